# Optimizing an MI355X kernel written in HIP

```python
import math
import jax, jax.numpy as jnp
from jax import lax
import numpy as np

D_MODEL = 1024
BATCH = 16
SEQ = 2048
DEPTH = 1

D_MIX = D_MODEL
HEAD_DIM = 64
D_ATTN = D_MIX // 2
N_Q_HEADS = D_ATTN // HEAD_DIM
N_KV_HEADS = 2
Q_PER_KV = N_Q_HEADS // N_KV_HEADS
WINDOW = 128
BLOCK = WINDOW
D_SSM = D_MIX - D_ATTN
SSM_GROUP = 16
N_SSM_GROUPS = D_SSM // SSM_GROUP
STATE = 64
D_KV = N_KV_HEADS * HEAD_DIM
D_IN = D_ATTN + 2 * D_KV + D_SSM
D_FF = ((8 * D_MODEL // 3 + 127) // 128) * 128
N_MOD = 9
EPS = 1e-6

kernel_name = "hybrid_swa_sinks_s5_macaron_sandwich_adaln"


def rms_norm(x, g):
    xf = x.astype(jnp.float32)
    y = xf * lax.rsqrt(jnp.mean(xf * xf, axis=-1, keepdims=True) + EPS)
    return (y * g.astype(jnp.float32)).astype(x.dtype)


def modulate(h, shift, scale):
    return h * (1.0 + scale[:, None, :]) + shift[:, None, :]


def swiglu(h, w_gate, w_up, w_down):
    return (jax.nn.silu(h @ w_gate) * (h @ w_up)) @ w_down


def alibi_slopes():
    i = jnp.arange(1, N_Q_HEADS + 1, dtype=jnp.float32)
    return jnp.exp2(-8.0 * i / N_Q_HEADS)


def sliding_window_attention(q, k, v, sinks):
    b, s = q.shape[0], q.shape[1]
    nb = s // BLOCK
    qb = q.reshape(b, nb, BLOCK, N_KV_HEADS, Q_PER_KV, HEAD_DIM)
    kb = k.reshape(b, nb, BLOCK, N_KV_HEADS, HEAD_DIM)
    vb = v.reshape(b, nb, BLOCK, N_KV_HEADS, HEAD_DIM)
    pad = ((0, 0), (1, 0), (0, 0), (0, 0), (0, 0))
    kk = jnp.concatenate([jnp.pad(kb[:, :-1], pad), kb], axis=2)
    vv = jnp.concatenate([jnp.pad(vb[:, :-1], pad), vb], axis=2)

    scores = jnp.einsum('bnqkgd,bnjkd->bnkgqj', qb, kk).astype(jnp.float32) * (HEAD_DIM ** -0.5)

    qi = jnp.arange(BLOCK)[:, None]
    kj = jnp.arange(2 * BLOCK)[None, :]
    dist = qi + BLOCK - kj
    key_pos = jnp.arange(nb)[:, None, None] * BLOCK + kj[None] - BLOCK
    valid = (dist[None] >= 0) & (dist[None] < WINDOW) & (key_pos >= 0)

    slopes = alibi_slopes().reshape(N_KV_HEADS, Q_PER_KV)
    bias = -slopes[:, :, None, None] * dist.astype(jnp.float32)[None, None]
    scores = jnp.where(valid[None, :, None, None], scores + bias, -jnp.inf)

    sink = sinks.astype(jnp.float32).reshape(N_KV_HEADS, Q_PER_KV)[None, None, :, :, None, None]
    m = jnp.maximum(jnp.max(scores, axis=-1, keepdims=True), sink)
    p = jnp.exp(scores - m)
    p = p / (jnp.sum(p, axis=-1, keepdims=True) + jnp.exp(sink - m))
    out = jnp.einsum('bnkgqj,bnjkd->bnqkgd', p.astype(v.dtype), vv)
    return out.reshape(b, s, N_Q_HEADS * HEAD_DIM)


def s5_ssm(u, a_re, a_im, log_step, b_re, b_im, c_re, c_im, d_skip, w_glu, b_glu):
    f32 = jnp.float32
    bsz, s = u.shape[0], u.shape[1]
    uf = u.astype(f32).reshape(bsz, s, N_SSM_GROUPS, SSM_GROUP)
    lam = lax.complex(a_re.astype(f32), a_im.astype(f32))
    dt = jnp.exp(log_step.astype(f32))[:, None]
    lam_bar = jnp.exp(lam * dt)
    b_mat = lax.complex(b_re.astype(f32), b_im.astype(f32))
    b_bar = ((lam_bar - 1.0) / lam)[:, :, None] * b_mat
    bu = jnp.einsum('bsgh,gph->bsgp', uf.astype(jnp.complex64), b_bar)
    a = jnp.broadcast_to(lam_bar, bu.shape)

    def combine(left, right):
        a_l, b_l = left
        a_r, b_r = right
        return a_r * a_l, a_r * b_l + b_r

    _, states = lax.associative_scan(combine, (a, bu), axis=1)
    c_mat = lax.complex(c_re.astype(f32), c_im.astype(f32))
    y = jnp.real(jnp.einsum('bsgp,ghp->bsgh', states, c_mat))
    y = y + uf * d_skip.astype(f32).reshape(N_SSM_GROUPS, SSM_GROUP)
    y = jax.nn.gelu(y.reshape(bsz, s, D_SSM))
    y = y * jax.nn.sigmoid(y @ w_glu.astype(f32) + b_glu.astype(f32))
    return y.astype(u.dtype)


def setup_inputs(seed: int = 0) -> dict:
    key = jax.random.key(seed)
    ks = jax.random.split(key, 40)
    f32 = jnp.float32
    L = DEPTH
    nrm = lambda k, shape, s: jax.random.normal(k, shape, f32) * s
    gain = lambda k: 1.0 + 0.05 * jax.random.normal(k, (L, D_MODEL), f32)
    n_idx = jnp.arange(STATE, dtype=f32)
    return {
        "x": jax.random.normal(ks[0], (BATCH, SEQ, D_MODEL), f32),
        "c": jax.random.normal(ks[1], (BATCH, D_MODEL), f32),
        "w_ada": nrm(ks[2], (L, D_MODEL, N_MOD * D_MODEL), 0.5 * D_MODEL ** -0.5),
        "b_ada": nrm(ks[3], (L, N_MOD * D_MODEL), 0.02),
        "g_pre_ff1": gain(ks[4]),
        "g_post_ff1": gain(ks[5]),
        "w1_gate": nrm(ks[6], (L, D_MODEL, D_FF), D_MODEL ** -0.5),
        "w1_up": nrm(ks[7], (L, D_MODEL, D_FF), D_MODEL ** -0.5),
        "w1_down": nrm(ks[8], (L, D_FF, D_MODEL), D_FF ** -0.5),
        "g_pre_mix": gain(ks[9]),
        "g_post_mix": gain(ks[10]),
        "w_in": nrm(ks[11], (L, D_MODEL, D_IN), D_MODEL ** -0.5),
        "attn_sinks": nrm(ks[12], (L, N_Q_HEADS), 1.0),
        "ssm_a_re": -0.5 + 0.01 * jax.random.normal(ks[13], (L, N_SSM_GROUPS, STATE), f32),
        "ssm_a_im": math.pi * n_idx + 0.01 * jax.random.normal(ks[14], (L, N_SSM_GROUPS, STATE), f32),
        "ssm_log_step": jax.random.uniform(ks[15], (L, N_SSM_GROUPS), f32, math.log(1e-3), math.log(1e-1)),
        "ssm_b_re": nrm(ks[16], (L, N_SSM_GROUPS, STATE, SSM_GROUP), (2 * SSM_GROUP) ** -0.5),
        "ssm_b_im": nrm(ks[17], (L, N_SSM_GROUPS, STATE, SSM_GROUP), (2 * SSM_GROUP) ** -0.5),
        "ssm_c_re": nrm(ks[18], (L, N_SSM_GROUPS, SSM_GROUP, STATE), (2 * STATE) ** -0.5),
        "ssm_c_im": nrm(ks[19], (L, N_SSM_GROUPS, SSM_GROUP, STATE), (2 * STATE) ** -0.5),
        "ssm_d": nrm(ks[20], (L, D_SSM), 1.0),
        "ssm_w_glu": nrm(ks[21], (L, D_SSM, D_SSM), D_SSM ** -0.5),
        "ssm_b_glu": nrm(ks[22], (L, D_SSM), 0.02),
        "g_attn_out": 1.0 + 0.05 * jax.random.normal(ks[23], (L, D_ATTN), f32),
        "g_ssm_out": 1.0 + 0.05 * jax.random.normal(ks[24], (L, D_SSM), f32),
        "w_out": nrm(ks[25], (L, D_MIX, D_MODEL), D_MIX ** -0.5),
        "g_pre_ff2": gain(ks[26]),
        "g_post_ff2": gain(ks[27]),
        "w2_gate": nrm(ks[28], (L, D_MODEL, D_FF), D_MODEL ** -0.5),
        "w2_up": nrm(ks[29], (L, D_MODEL, D_FF), D_MODEL ** -0.5),
        "w2_down": nrm(ks[30], (L, D_FF, D_MODEL), D_FF ** -0.5),
    }


def reference(x, c, w_ada, b_ada, g_pre_ff1, g_post_ff1, w1_gate, w1_up, w1_down,
              g_pre_mix, g_post_mix, w_in, attn_sinks, ssm_a_re, ssm_a_im, ssm_log_step,
              ssm_b_re, ssm_b_im, ssm_c_re, ssm_c_im, ssm_d, ssm_w_glu, ssm_b_glu,
              g_attn_out, g_ssm_out, w_out, g_pre_ff2, g_post_ff2, w2_gate, w2_up, w2_down):
    bsz, s = x.shape[0], x.shape[1]
    c_act = jax.nn.silu(c)
    for l in range(DEPTH):
        mod = c_act @ w_ada[l] + b_ada[l]
        (sh1, sc1, ga1, sh2, sc2, ga2, sh3, sc3, ga3) = jnp.split(mod, N_MOD, axis=-1)

        h = modulate(rms_norm(x, g_pre_ff1[l]), sh1, sc1)
        f = swiglu(h, w1_gate[l], w1_up[l], w1_down[l])
        x = x + 0.5 * ga1[:, None, :] * rms_norm(f, g_post_ff1[l])

        h = modulate(rms_norm(x, g_pre_mix[l]), sh2, sc2)
        proj = h @ w_in[l]
        q = proj[..., :D_ATTN].reshape(bsz, s, N_Q_HEADS, HEAD_DIM)
        k = proj[..., D_ATTN:D_ATTN + D_KV].reshape(bsz, s, N_KV_HEADS, HEAD_DIM)
        v = proj[..., D_ATTN + D_KV:D_ATTN + 2 * D_KV].reshape(bsz, s, N_KV_HEADS, HEAD_DIM)
        u = proj[..., D_ATTN + 2 * D_KV:]
        attn = sliding_window_attention(q, k, v, attn_sinks[l])
        ssm = s5_ssm(u, ssm_a_re[l], ssm_a_im[l], ssm_log_step[l], ssm_b_re[l], ssm_b_im[l],
                     ssm_c_re[l], ssm_c_im[l], ssm_d[l], ssm_w_glu[l], ssm_b_glu[l])
        mixed = jnp.concatenate([rms_norm(attn, g_attn_out[l]), rms_norm(ssm, g_ssm_out[l])], axis=-1)
        mixed = mixed @ w_out[l]
        x = x + ga2[:, None, :] * rms_norm(mixed, g_post_mix[l])

        h = modulate(rms_norm(x, g_pre_ff2[l]), sh3, sc3)
        f = swiglu(h, w2_gate[l], w2_up[l], w2_down[l])
        x = x + 0.5 * ga3[:, None, :] * rms_norm(f, g_post_ff2[l])
    return x
```

```cpp
#include <hip/hip_runtime.h>
#include <hip/hip_cooperative_groups.h>
#include <cstdio>
#include <cstdint>
namespace cg = cooperative_groups;
namespace pg8 {
#define PG8_LAS __attribute__((address_space(3)))
typedef unsigned short bf16_t;
typedef short bf16x8 __attribute__((ext_vector_type(8)));
typedef float f32x4 __attribute__((ext_vector_type(4)));
typedef unsigned u32x4 __attribute__((ext_vector_type(4)));
constexpr int BM = 256, BK = 64, HALF = 128, HTB = HALF * BK * 2  , STAGE_BYTES = 8 * HTB, NXCD = 8, WGM = 8;

__host__ __device__ __forceinline__ int lds_byte(int r, int c) { const int st = (r >> 4) * 2 + (c >> 5), rr = r & 15, cc = c & 31, ob = rr * 64 + cc * 2; return st * 1024 + (ob ^ (((ob >> 9) & 1) << 5)); }
__host__ __device__ __forceinline__ void stage_rc(int b, int& R, int& C) { const int st = b / 1024, sb = b % 1024, swz = sb ^ (((sb >> 9) & 1) << 5); R = (st >> 1) * 16 + swz / 64; C = (st & 1) * 32 + (swz % 64) / 2; }
__host__ __device__ __forceinline__ int perm32(int rho) { const int n = rho >> 4, i = rho & 15; return 8 * (i >> 2) + 4 * n + (i & 3); }

struct Unit { int pm, pn; };
struct Gemm { const bf16_t* A; const bf16_t* Bt; int M, N, K; };

struct StaticOrder {
    int nM, nN, nwg, G, c;
    __host__ __device__ void init(int M, int N, int G_, int c_) { nM = M / BM; nN = N / BM; nwg = nM * nN; G = G_; c = c_; }
    __host__ __device__ bool next(int i, Unit& u) const {
        const long L = (long)i * G + c; if (L >= nwg) return false;
        int wgid = (int)L; { const int q = nwg / NXCD, r = nwg % NXCD, xcd = wgid % NXCD, off = wgid / NXCD; wgid = (xcd < r ? xcd * (q + 1) : r * (q + 1) + (xcd - r) * q) + off; }
        const int nig = WGM * nN, gid = wgid / nig, fm = gid * WGM, gsz = (nM - fm) < WGM ? (nM - fm) : WGM;
        u.pm = fm + ((wgid % nig) % gsz); u.pn = (wgid % nig) / gsz; return true;
    }
    __device__ __forceinline__ void a_ready(const Unit&) const {}
    __device__ __forceinline__ void done(const Unit&) const {}
};

__device__ __forceinline__ unsigned cvt_pk_bf16(float lo, float hi) { unsigned r; asm volatile("v_cvt_pk_bf16_f32 %0, %1, %2" : "=v"(r) : "v"(lo), "v"(hi)); return r; }
typedef float f32x2 __attribute__((ext_vector_type(2)));
__device__ __forceinline__ f32x2 gelu_pk(f32x2 v) {
    const f32x2 av = __builtin_elementwise_abs(v), d = av * 0.2316418882f + 1.0f;
    f32x2 t; t.x = __builtin_amdgcn_rcpf(d.x); t.y = __builtin_amdgcn_rcpf(d.y);
    f32x2 q = t * 0.5307027145f + (-0.7265760135f); q = q * t + 0.7107068705f; q = q * t + (-0.142248368f); q = q * t + 0.127414796f; q = q * t;
    const f32x2 s = (v * v) * (-0.72134752044f);
    f32x2 e; e.x = __builtin_amdgcn_exp2f(s.x); e.y = __builtin_amdgcn_exp2f(s.y);
    const f32x2 m = v * (q * e), r = v - m;
    f32x2 o; o.x = v.x < 0.f ? m.x : r.x; o.y = v.y < 0.f ? m.y : r.y; return o;
}

template <int ACT  > struct EpiBf16 {
    static constexpr bool PERM = true, AFTER_DRAIN = false; static_assert(ACT == 0 || ACT == 1, "EpiBf16: ACT is 0 (none) or 1 (gelu_pk)");
    bf16_t* O; int ldc; const float* bias; int split_cols; size_t split_stride; float scale0;
    __device__ __forceinline__ void operator()(const f32x4 (&acc)[2][2][4][2], const Unit& u, int wr, int wc, int fr, int fq) const {
        const int row0 = u.pm * BM + wr * 64 + fr; int colt = u.pn * BM; bf16_t* base = O;
        float sc = 1.f; if (split_cols) { const int t = colt / split_cols; base += (size_t)t * split_stride; colt -= t * split_cols; if (t == 0) sc = scale0; }
        const int col0 = colt + wc * 32 + 8 * fq, bcol0 = u.pn * BM + wc * 32 + 8 * fq;
        f32x4 bv[2][2];
#pragma unroll
        for (int bj = 0; bj < 2; ++bj)
#pragma unroll
            for (int n = 0; n < 2; ++n) bv[bj][n] = bias ? *(const f32x4*)(bias + bcol0 + bj * HALF + 4 * n) : (f32x4){0.f, 0.f, 0.f, 0.f};
#pragma unroll
        for (int ai = 0; ai < 2; ++ai)
#pragma unroll
            for (int m = 0; m < 4; ++m) { bf16_t* rowp = base + (size_t)(row0 + ai * HALF + m * 16) * ldc + col0;
#pragma unroll
                for (int bj = 0; bj < 2; ++bj) { f32x4 v0 = acc[ai][bj][m][0] + bv[bj][0], v1 = acc[ai][bj][m][1] + bv[bj][1];
                    if (ACT == 1) { f32x2 a = gelu_pk((f32x2){v0[0], v0[1]}), b = gelu_pk((f32x2){v0[2], v0[3]}), c = gelu_pk((f32x2){v1[0], v1[1]}), d = gelu_pk((f32x2){v1[2], v1[3]});
                        v0 = (f32x4){a.x, a.y, b.x, b.y}; v1 = (f32x4){c.x, c.y, d.x, d.y}; }
                    v0 = v0 * sc; v1 = v1 * sc; u32x4 w; w.x = cvt_pk_bf16(v0[0], v0[1]); w.y = cvt_pk_bf16(v0[2], v0[3]); w.z = cvt_pk_bf16(v1[0], v1[1]); w.w = cvt_pk_bf16(v1[2], v1[3]);
                    *(u32x4*)(rowp + bj * HALF) = w; } }
    }
};

struct PanelStats {
    unsigned* xbuf;
    unsigned* cnt;
    unsigned* tmo;
    int ntn; float eps;
    unsigned code;
    __device__ __forceinline__ bool run(const f32x4 (&v)[2][2][4][2], const Unit& u, int wr, int wc, int fr, int fq, PG8_LAS unsigned char* lds, int wid, int lane) const {
        typedef float f32x2v __attribute__((ext_vector_type(2)));
        PG8_LAS f32x2v* P = (PG8_LAS f32x2v*)lds;
        PG8_LAS f32x2v* S = (PG8_LAS f32x2v*)(lds + 8192);
        PG8_LAS unsigned* flag = (PG8_LAS unsigned*)(lds + 8192 + 2048);
#pragma unroll
        for (int ai = 0; ai < 2; ++ai)
#pragma unroll
            for (int m = 0; m < 4; ++m) {
                float s = 0.f;
#pragma unroll
                for (int bj = 0; bj < 2; ++bj)
#pragma unroll
                    for (int n = 0; n < 2; ++n) { const f32x4 x = v[ai][bj][m][n]; s += (x[0] + x[1]) + (x[2] + x[3]); }
                s += __shfl_xor(s, 16); s += __shfl_xor(s, 32);
                const float mw = s * (1.0f / 64.0f); float q = 0.f;
#pragma unroll
                for (int bj = 0; bj < 2; ++bj)
#pragma unroll
                    for (int n = 0; n < 2; ++n) { const f32x4 d = v[ai][bj][m][n] - mw; q += (d[0] * d[0] + d[1] * d[1]) + (d[2] * d[2] + d[3] * d[3]); }
                q += __shfl_xor(q, 16); q += __shfl_xor(q, 32);
                if (fq == 0) P[(ai * HALF + wr * 64 + m * 16 + fr) * 4 + wc] = (f32x2v){mw, q};
            }
        asm volatile("s_waitcnt lgkmcnt(0)" ::: "memory"); __builtin_amdgcn_s_barrier(); asm volatile("" ::: "memory");
#if defined(BROKEN_EXCHANGE_NO_WAIT)
#warning BROKEN CONTROL BUILD: the row-statistics exchange does not wait; results are wrong by design
        if (blockIdx.x >= 64) { const long long t0_ = clock64(); while (clock64() - t0_ < 60000) __builtin_amdgcn_s_sleep(8); }
#endif
        const int row = wid * 32 + (lane & 31);
        if (lane < 32) {
            const f32x2v a = P[row * 4 + 0], b = P[row * 4 + 1], c = P[row * 4 + 2], d = P[row * 4 + 3];
            const float mt = (a.x + b.x + c.x + d.x) * 0.25f;
            const float da = a.x - mt, db = b.x - mt, dc = c.x - mt, dd = d.x - mt;
            const float m2 = (a.y + b.y) + (c.y + d.y) + 64.0f * ((da * da + db * db) + (dc * dc + dd * dd));
            unsigned long long* slot = (unsigned long long*)xbuf + ((size_t)(u.pm * BM + row) * 4 + u.pn);
            __hip_atomic_store(slot, ((unsigned long long)__float_as_uint(m2) << 32) | __float_as_uint(mt), __ATOMIC_RELAXED, __HIP_MEMORY_SCOPE_AGENT);
        }
        asm volatile("s_waitcnt vmcnt(0)" ::: "memory");
        if (lane == 0) __hip_atomic_fetch_add(cnt + 64 * u.pm, 1u, __ATOMIC_RELAXED, __HIP_MEMORY_SCOPE_AGENT);
        if (wid == 0) {
            bool dead = false; const unsigned long long t0 = __builtin_amdgcn_s_memrealtime(); const unsigned want = 8u * (unsigned)ntn;
            for (;;) {
#if defined(BROKEN_EXCHANGE_NO_WAIT)
                break;
#endif
                if ((unsigned)__builtin_amdgcn_readfirstlane(__hip_atomic_load(cnt + 64 * u.pm, __ATOMIC_RELAXED, __HIP_MEMORY_SCOPE_AGENT)) >= want) break;
                if (__builtin_amdgcn_s_memrealtime() - t0 > 2000000ull) {
                    if (lane == 0) { unsigned expect = 0u; __hip_atomic_compare_exchange_strong(tmo + 1, &expect, code | (unsigned)(u.pm & 0xff), __ATOMIC_RELAXED, __ATOMIC_RELAXED, __HIP_MEMORY_SCOPE_AGENT);
                                     __hip_atomic_store(tmo, 1u, __ATOMIC_RELAXED, __HIP_MEMORY_SCOPE_AGENT); }
                    dead = true; break; }
                __builtin_amdgcn_s_sleep(2);
            }
            __builtin_amdgcn_fence(__ATOMIC_ACQUIRE, "agent");
            if (lane == 0) flag[0] = dead ? 1u : 0u;
        }
        asm volatile("s_waitcnt vmcnt(0) lgkmcnt(0)" ::: "memory"); __builtin_amdgcn_s_barrier(); asm volatile("" ::: "memory");
        const bool bad = flag[0] != 0u;
        if (lane < 32) {
            const unsigned long long* slot = (const unsigned long long*)xbuf + (size_t)(u.pm * BM + row) * 4; float mt[4], m2[4]; float ms = 0.f;
#pragma unroll
            for (int t = 0; t < 4; ++t) { if (t < ntn) { const unsigned long long w = __hip_atomic_load(slot + t, __ATOMIC_RELAXED, __HIP_MEMORY_SCOPE_AGENT); mt[t] = __uint_as_float((unsigned)w); m2[t] = __uint_as_float((unsigned)(w >> 32)); } else { mt[t] = 0.f; m2[t] = 0.f; } ms += mt[t]; }
            const float mean = ms / (float)ntn; float q = 0.f;
#pragma unroll
            for (int t = 0; t < 4; ++t) if (t < ntn) { const float dm = mt[t] - mean; q += m2[t] + 256.0f * dm * dm; }
            S[row] = (f32x2v){mean, 1.0f / sqrtf(q / (256.0f * (float)ntn) + eps)};
        }
        asm volatile("s_waitcnt lgkmcnt(0)" ::: "memory"); __builtin_amdgcn_s_barrier(); asm volatile("" ::: "memory");
        return bad;
    }
};
struct EpiLnRes {
    static constexpr bool PERM = false, AFTER_DRAIN = true;
    const float* base; float* out; int ldc; const float* bias; PanelStats st; unsigned poison;
    __device__ __forceinline__ void fused(f32x4 (&acc)[2][2][4][2], const Unit& u, int wr, int wc, int fr, int fq, PG8_LAS unsigned char* lds, int wid, int lane) const {
        typedef float f32x2v __attribute__((ext_vector_type(2)));
        const PG8_LAS f32x2v* S = (const PG8_LAS f32x2v*)(lds + 8192);
        const int col0 = u.pn * BM + wc * 32 + 4 * fq;
#pragma unroll
        for (int bj = 0; bj < 2; ++bj)
#pragma unroll
            for (int n = 0; n < 2; ++n) { const f32x4 bv = bias ? *(const f32x4*)(bias + col0 + bj * HALF + n * 16) : (f32x4){0.f, 0.f, 0.f, 0.f};
#pragma unroll
                for (int ai = 0; ai < 2; ++ai)
#pragma unroll
                    for (int m = 0; m < 4; ++m) acc[ai][bj][m][n] += bv; }
        f32x4 pre[4][2][2];
#pragma unroll
        for (int m = 0; m < 4; ++m) { const size_t off = (size_t)(u.pm * BM + wr * 64 + m * 16 + fr) * ldc + col0;
#pragma unroll
            for (int bj = 0; bj < 2; ++bj)
#pragma unroll
                for (int n = 0; n < 2; ++n) pre[m][bj][n] = *(const f32x4*)(base + off + bj * HALF + n * 16); }
        const bool bad = st.run(acc, u, wr, wc, fr, fq, lds, wid, lane) || poison != 0u;
        const float qnan = __builtin_nanf("");
#pragma unroll
        for (int ai = 0; ai < 2; ++ai)
#pragma unroll
            for (int m = 0; m < 4; ++m) { const int r = ai * HALF + wr * 64 + m * 16 + fr; const f32x2v sr = S[r]; const size_t off = (size_t)(u.pm * BM + r) * ldc + col0;
#pragma unroll
                for (int bj = 0; bj < 2; ++bj)
#pragma unroll
                    for (int n = 0; n < 2; ++n) { const f32x4 bs = ai == 0 ? pre[m][bj][n] : *(const f32x4*)(base + off + bj * HALF + n * 16); f32x4 o = bs + (acc[ai][bj][m][n] - sr.x) * sr.y;
                        if (bad) o = (f32x4){qnan, qnan, qnan, qnan}; *(f32x4*)(out + off + bj * HALF + n * 16) = o; }
                if (m & 1) asm volatile("" ::: "memory"); }
    }
};
struct EpiLnResLn {
    static constexpr bool PERM = false, AFTER_DRAIN = true;
    const float* base; float* out; bf16_t* xn; int ldc; const float* bias; PanelStats st1, st2; unsigned poison;
    __device__ __forceinline__ void fused(f32x4 (&acc)[2][2][4][2], const Unit& u, int wr, int wc, int fr, int fq, PG8_LAS unsigned char* lds, int wid, int lane) const {
        typedef float f32x2v __attribute__((ext_vector_type(2))); typedef unsigned u32x2v __attribute__((ext_vector_type(2)));
        const PG8_LAS f32x2v* S = (const PG8_LAS f32x2v*)(lds + 8192);
        const int col0 = u.pn * BM + wc * 32 + 4 * fq;
#pragma unroll
        for (int bj = 0; bj < 2; ++bj)
#pragma unroll
            for (int n = 0; n < 2; ++n) { const f32x4 bv = bias ? *(const f32x4*)(bias + col0 + bj * HALF + n * 16) : (f32x4){0.f, 0.f, 0.f, 0.f};
#pragma unroll
                for (int ai = 0; ai < 2; ++ai)
#pragma unroll
                    for (int m = 0; m < 4; ++m) acc[ai][bj][m][n] += bv; }
        bool bad = st1.run(acc, u, wr, wc, fr, fq, lds, wid, lane) || poison != 0u;
        const float qnan = __builtin_nanf("");
#pragma unroll
        for (int ai = 0; ai < 2; ++ai)
#pragma unroll
            for (int m = 0; m < 4; ++m) { const int r = ai * HALF + wr * 64 + m * 16 + fr; const f32x2v sr = S[r]; const size_t off = (size_t)(u.pm * BM + r) * ldc + col0;
#pragma unroll
                for (int bj = 0; bj < 2; ++bj)
#pragma unroll
                    for (int n = 0; n < 2; ++n) { const f32x4 bs = *(const f32x4*)(base + off + bj * HALF + n * 16); acc[ai][bj][m][n] = bs + (acc[ai][bj][m][n] - sr.x) * sr.y; }
                asm volatile("" : "+v"(acc[ai][0][m][0]), "+v"(acc[ai][0][m][1]), "+v"(acc[ai][1][m][0]), "+v"(acc[ai][1][m][1]));
                if (m & 1) asm volatile("" ::: "memory"); }
        const bool bad1 = bad;
        bad = st2.run(acc, u, wr, wc, fr, fq, lds, wid, lane) || bad;
#pragma unroll
        for (int ai = 0; ai < 2; ++ai)
#pragma unroll
            for (int m = 0; m < 4; ++m) { const int r = ai * HALF + wr * 64 + m * 16 + fr; const f32x2v sr = S[r]; const size_t off = (size_t)(u.pm * BM + r) * ldc + col0;
#pragma unroll
                for (int bj = 0; bj < 2; ++bj)
#pragma unroll
                    for (int n = 0; n < 2; ++n) { const f32x4 x1 = acc[ai][bj][m][n]; *(f32x4*)(out + off + bj * HALF + n * 16) = bad1 ? (f32x4){qnan, qnan, qnan, qnan} : x1;
                        const f32x4 o = (x1 - sr.x) * sr.y; u32x2v w; w.x = cvt_pk_bf16(o[0], o[1]); w.y = cvt_pk_bf16(o[2], o[3]);
                        if (bad) { w.x = 0x7fc07fc0u; w.y = 0x7fc07fc0u; } *(u32x2v*)(xn + off + bj * HALF + n * 16) = w; }
                asm volatile("" ::: "memory"); }
    }
};

template <class Epi, class Sched, bool ALIGN_EPI = false, bool SP2 = false>
__device__ __forceinline__ void gemm_phase(PG8_LAS unsigned char* lds, const Gemm g, const Sched& S, const Epi& E) {
    int tid_ = threadIdx.x; asm volatile("" : "+v"(tid_));
    const int tid = tid_, wid = __builtin_amdgcn_readfirstlane(tid >> 6), lane = tid & 63, wr = wid >> 2, wc = wid & 3, fr = lane & 15, fq = lane >> 4;
    const int K = g.K, nt = K / BK;
    unsigned voffA[2], voffB[2];
#pragma unroll
    for (int i = 0; i < 2; ++i) { int R, C; stage_rc(tid * 16 + i * 8192, R, C); const int Rb = Epi::PERM ? ((R & ~31) + perm32(R & 31)) : R;
        voffA[i] = (unsigned)(R * K + C) * 2u; voffB[i] = (unsigned)(Rb * K + C) * 2u; }
    const size_t kstep = (size_t)(BK * 2);
    const size_t hstep = (size_t)HALF * K * 2;
    const size_t tstep = 2 * hstep;
    const unsigned ldsw = (unsigned)wid * 1024u;
    const int aoff = lds_byte(wr * 64 + fr, fq * 8), boff = lds_byte(wc * 32 + fr, fq * 8);
#define PG8_SA(b, h) (((b) * 2 + (h)) * HTB)
#define PG8_SB(b, h) ((4 + (b) * 2 + (h)) * HTB)
#define PG8_STAGE(bufoff, gbase, voff) do { _Pragma("unroll") for (int _i = 0; _i < 2; ++_i) \
        __builtin_amdgcn_global_load_lds((const unsigned*)((const char*)(gbase) + (voff)[_i]), (PG8_LAS unsigned*)(lds + (bufoff) + ldsw + _i * 8192), 16, 0, 0); } while (0)
#define PG8_LDA(dst, b, h) do { _Pragma("unroll") for (int m = 0; m < 4; ++m) _Pragma("unroll") for (int k = 0; k < 2; ++k) dst[m][k] = *(const PG8_LAS bf16x8*)(lds + PG8_SA(b, h) + aoff + m * 2048 + k * 1024); } while (0)
#define PG8_LDB(dst, b, h) do { _Pragma("unroll") for (int n = 0; n < 2; ++n) _Pragma("unroll") for (int k = 0; k < 2; ++k) dst[n][k] = *(const PG8_LAS bf16x8*)(lds + PG8_SB(b, h) + boff + n * 2048 + k * 1024); } while (0)
#define PG8_MMA(ai, bj, At, Bt) do { __builtin_amdgcn_s_setprio(1); _Pragma("unroll") for (int m = 0; m < 4; ++m) _Pragma("unroll") for (int n = 0; n < 2; ++n) _Pragma("unroll") for (int k = 0; k < 2; ++k) \
        acc[ai][bj][m][n] = __builtin_amdgcn_mfma_f32_16x16x32_bf16(Bt[n][k], At[m][k], acc[ai][bj][m][n], 0, 0, 0); __builtin_amdgcn_s_setprio(0); } while (0)
#define PG8_WAIT_V(n) asm volatile("s_waitcnt vmcnt(" #n ")" ::: "memory")
#define PG8_WAIT_L(n) asm volatile("s_waitcnt lgkmcnt(" #n ")" ::: "memory")
#define PG8_BAR __builtin_amdgcn_s_barrier()
#define PG8_SCHED __builtin_amdgcn_sched_barrier(0)
    Unit cur, nxt; int ui = 0;
    if (!S.next(0, cur)) return;
    f32x4 acc[2][2][4][2];
#pragma unroll
    for (int a = 0; a < 2; ++a)
#pragma unroll
        for (int b = 0; b < 2; ++b)
#pragma unroll
            for (int m = 0; m < 4; ++m)
#pragma unroll
                for (int n = 0; n < 2; ++n) acc[a][b][m][n] = (f32x4){0.f, 0.f, 0.f, 0.f};
    bf16x8 At[4][2], B0[2][2], B1[2][2];
    const char* cA = (const char*)g.A + (size_t)cur.pm * tstep; const char* cB = (const char*)g.Bt + (size_t)cur.pn * tstep;
    S.a_ready(cur);
    if constexpr (SP2) {
        PG8_STAGE(PG8_SB(0, 0), cB, voffB); PG8_STAGE(PG8_SB(0, 1), cB + hstep, voffB); PG8_STAGE(PG8_SA(0, 0), cA, voffA); PG8_STAGE(PG8_SA(0, 1), cA + hstep, voffA);
        if (wr == 1) PG8_BAR;
        PG8_WAIT_V(2); PG8_BAR;
        PG8_STAGE(PG8_SB(1, 0), cB + kstep, voffB); PG8_STAGE(PG8_SA(1, 0), cA + kstep, voffA); PG8_STAGE(PG8_SB(1, 1), cB + hstep + kstep, voffB);
        PG8_WAIT_V(6); PG8_BAR;
    } else {
        PG8_STAGE(PG8_SB(0, 0), cB, voffB); PG8_STAGE(PG8_SA(0, 0), cA, voffA); PG8_STAGE(PG8_SB(0, 1), cB + hstep, voffB); PG8_STAGE(PG8_SA(0, 1), cA + hstep, voffA);
        if (wr == 1) PG8_BAR;
        PG8_WAIT_V(4); PG8_BAR;
        PG8_STAGE(PG8_SB(1, 0), cB + kstep, voffB); PG8_STAGE(PG8_SA(1, 0), cA + kstep, voffA); PG8_STAGE(PG8_SB(1, 1), cB + hstep + kstep, voffB);
        PG8_WAIT_V(6); PG8_BAR;
    }
    for (;;) {
        const bool has_next = S.next(ui + 1, nxt);
        const char* nA = has_next ? (const char*)g.A + (size_t)nxt.pm * tstep : cA; const char* nB = has_next ? (const char*)g.Bt + (size_t)nxt.pn * tstep : cB;
        for (int t = 0; t < nt; t += 2) {
            const bool last = (t == nt - 2);
            const char* a1 = cA + (size_t)(t + 1) * kstep;
            const char* a2 = last ? nA : cA + (size_t)(t + 2) * kstep; const char* b2 = last ? nB : cB + (size_t)(t + 2) * kstep;
            const char* a3 = a2 + kstep; const char* b3 = b2 + kstep;
            if (last && has_next) S.a_ready(nxt);
            if constexpr (SP2) {
            PG8_LDB(B0, 0, 0); PG8_LDB(B1, 0, 1); PG8_SCHED; PG8_LDA(At, 0, 0); PG8_STAGE(PG8_SA(1, 1), a1 + hstep, voffA);
            PG8_WAIT_V(8); PG8_WAIT_L(0); PG8_BAR; PG8_MMA(0, 0, At, B0); PG8_MMA(0, 1, At, B1); PG8_BAR; PG8_SCHED;
            PG8_LDA(At, 0, 1); PG8_STAGE(PG8_SB(0, 0), b2, voffB); PG8_STAGE(PG8_SB(0, 1), b2 + hstep, voffB); PG8_STAGE(PG8_SA(0, 0), a2, voffA);
            PG8_WAIT_V(8); PG8_WAIT_L(0); PG8_BAR; PG8_MMA(1, 0, At, B0); PG8_MMA(1, 1, At, B1); PG8_BAR; PG8_SCHED;
            PG8_LDB(B0, 1, 0); PG8_LDB(B1, 1, 1); PG8_SCHED; PG8_LDA(At, 1, 0); PG8_STAGE(PG8_SA(0, 1), a2 + hstep, voffA);
            PG8_WAIT_V(8); PG8_WAIT_L(0); PG8_BAR; PG8_MMA(0, 0, At, B0); PG8_MMA(0, 1, At, B1); PG8_BAR; PG8_SCHED;
            PG8_LDA(At, 1, 1); PG8_STAGE(PG8_SB(1, 0), b3, voffB); PG8_STAGE(PG8_SB(1, 1), b3 + hstep, voffB); PG8_STAGE(PG8_SA(1, 0), a3, voffA);
            PG8_WAIT_V(8); PG8_WAIT_L(0); PG8_BAR; PG8_MMA(1, 0, At, B0); PG8_MMA(1, 1, At, B1); PG8_BAR; PG8_SCHED;
            } else {
            PG8_LDB(B0, 0, 0); PG8_SCHED; PG8_LDA(At, 0, 0); PG8_STAGE(PG8_SA(1, 1), a1 + hstep, voffA);
            PG8_WAIT_L(8); PG8_BAR; PG8_WAIT_L(0); PG8_MMA(0, 0, At, B0); PG8_BAR; PG8_SCHED;
            PG8_LDB(B1, 0, 1); PG8_STAGE(PG8_SB(0, 0), b2, voffB);
            PG8_BAR; PG8_WAIT_L(0); PG8_MMA(0, 1, At, B1); PG8_BAR;
            PG8_LDA(At, 0, 1); PG8_STAGE(PG8_SA(0, 0), a2, voffA);
            PG8_BAR; PG8_WAIT_L(0); PG8_MMA(1, 0, At, B0); PG8_BAR; PG8_SCHED;
            PG8_STAGE(PG8_SB(0, 1), b2 + hstep, voffB);
            PG8_WAIT_V(6); PG8_BAR; PG8_MMA(1, 1, At, B1); PG8_BAR;
            PG8_LDB(B0, 1, 0); PG8_SCHED; PG8_LDA(At, 1, 0); PG8_STAGE(PG8_SA(0, 1), a2 + hstep, voffA);
            PG8_WAIT_L(8); PG8_BAR; PG8_WAIT_L(0); PG8_MMA(0, 0, At, B0); PG8_BAR; PG8_SCHED;
            PG8_LDB(B1, 1, 1); PG8_STAGE(PG8_SB(1, 0), b3, voffB);
            PG8_BAR; PG8_WAIT_L(0); PG8_MMA(0, 1, At, B1); PG8_BAR;
            PG8_LDA(At, 1, 1); PG8_STAGE(PG8_SA(1, 0), a3, voffA);
            PG8_BAR; PG8_WAIT_L(0); PG8_MMA(1, 0, At, B0); PG8_BAR; PG8_SCHED;
            PG8_STAGE(PG8_SB(1, 1), b3 + hstep, voffB);
            PG8_WAIT_V(6); PG8_BAR; PG8_MMA(1, 1, At, B1); PG8_BAR;
            }
        }
        if constexpr (ALIGN_EPI) { if (wr == 0) PG8_BAR; }
        if constexpr (!Epi::AFTER_DRAIN) { E(acc, cur, wr, wc, fr, fq); S.done(cur); }
        if (!has_next) break;
#pragma unroll
        for (int a = 0; a < 2; ++a)
#pragma unroll
            for (int b = 0; b < 2; ++b)
#pragma unroll
                for (int m = 0; m < 4; ++m)
#pragma unroll
                    for (int n = 0; n < 2; ++n) acc[a][b][m][n] = (f32x4){0.f, 0.f, 0.f, 0.f};
        cur = nxt; cA = nA; cB = nB; ++ui;
        if constexpr (ALIGN_EPI) { if (wr == 1) PG8_BAR; }
    }
    PG8_WAIT_V(0);
    if constexpr (!ALIGN_EPI) { if (wr == 0) PG8_BAR; }
    PG8_BAR;
    if constexpr (Epi::AFTER_DRAIN) { E.fused(acc, cur, wr, wc, fr, fq, lds, wid, lane); S.done(cur); }
#undef PG8_SA
#undef PG8_SB
#undef PG8_STAGE
#undef PG8_LDA
#undef PG8_LDB
#undef PG8_MMA
#undef PG8_WAIT_V
#undef PG8_WAIT_L
#undef PG8_BAR
#undef PG8_SCHED
}
}
namespace pg8 {
constexpr float LOG2E = 1.4426950408889634f;
__device__ __forceinline__ float sigmoid_f(float z) { return __builtin_amdgcn_rcpf(1.0f + __builtin_amdgcn_exp2f(-LOG2E * z)); }
__device__ __forceinline__ float silu_f(float g) { return g * sigmoid_f(g); }
__device__ __forceinline__ float gelu_tanh_f(float x) { const float z = 1.5957691216057308f * (x + 0.044715f * x * x * x); return x * sigmoid_f(z); }
__device__ __forceinline__ float bf16_lo(unsigned w) { return __uint_as_float(w << 16); }
__device__ __forceinline__ float bf16_hi(unsigned w) { return __uint_as_float(w & 0xffff0000u); }

struct EpiSwiGLU {
    static constexpr bool PERM = true, AFTER_DRAIN = false;
    bf16_t* O; int ldc;
    __device__ __forceinline__ void operator()(const f32x4 (&acc)[2][2][4][2], const Unit& u, int wr, int wc, int fr, int fq) const {
        const int row0 = u.pm * BM + wr * 64 + fr, col0 = u.pn * HALF + wc * 32 + 8 * fq;
#pragma unroll
        for (int ai = 0; ai < 2; ++ai)
#pragma unroll
            for (int m = 0; m < 4; ++m) {
                bf16_t* p = O + (size_t)(row0 + ai * HALF + m * 16) * ldc + col0;
                const f32x4 g0 = acc[ai][0][m][0], g1 = acc[ai][0][m][1], u0 = acc[ai][1][m][0], u1 = acc[ai][1][m][1];
                u32x4 w;
                w.x = cvt_pk_bf16(silu_f(g0[0]) * u0[0], silu_f(g0[1]) * u0[1]); w.y = cvt_pk_bf16(silu_f(g0[2]) * u0[2], silu_f(g0[3]) * u0[3]);
                w.z = cvt_pk_bf16(silu_f(g1[0]) * u1[0], silu_f(g1[1]) * u1[1]); w.w = cvt_pk_bf16(silu_f(g1[2]) * u1[2], silu_f(g1[3]) * u1[3]);
                *(u32x4*)p = w;
            }
    }
};
struct EpiBf16SS {
    static constexpr bool PERM = true, AFTER_DRAIN = false;
    bf16_t* O; int ldc; float* ss; int ss_ld;
    __device__ __forceinline__ void operator()(const f32x4 (&acc)[2][2][4][2], const Unit& u, int wr, int wc, int fr, int fq) const {
        const int row0 = u.pm * BM + wr * 64 + fr, col0 = u.pn * BM + wc * 32 + 8 * fq;
#pragma unroll
        for (int ai = 0; ai < 2; ++ai)
#pragma unroll
            for (int m = 0; m < 4; ++m) {
                const int row = row0 + ai * HALF + m * 16; bf16_t* p = O + (size_t)row * ldc + col0; float q = 0.f;
#pragma unroll
                for (int bj = 0; bj < 2; ++bj) { const f32x4 v0 = acc[ai][bj][m][0], v1 = acc[ai][bj][m][1];
                    q += (v0[0] * v0[0] + v0[1] * v0[1]) + (v0[2] * v0[2] + v0[3] * v0[3]) + (v1[0] * v1[0] + v1[1] * v1[1]) + (v1[2] * v1[2] + v1[3] * v1[3]);
                    u32x4 w; w.x = cvt_pk_bf16(v0[0], v0[1]); w.y = cvt_pk_bf16(v0[2], v0[3]); w.z = cvt_pk_bf16(v1[0], v1[1]); w.w = cvt_pk_bf16(v1[2], v1[3]);
                    *(u32x4*)(p + bj * HALF) = w; }
                q += __shfl_xor(q, 16); q += __shfl_xor(q, 32);
                if (fq == 0) ss[(size_t)row * ss_ld + u.pn * 4 + wc] = q;
            }
    }
};
struct EpiWin {
    static constexpr bool PERM = true, AFTER_DRAIN = false;
    bf16_t* Q; bf16_t* Kb; bf16_t* Vb; bf16_t* As;
    __device__ __forceinline__ void operator()(const f32x4 (&acc)[2][2][4][2], const Unit& u, int wr, int wc, int fr, int fq) const {
        const int row0 = u.pm * BM + wr * 64 + fr, cl = wc * 32 + 8 * fq;
#pragma unroll
        for (int ai = 0; ai < 2; ++ai)
#pragma unroll
            for (int m = 0; m < 4; ++m) {
                const int row = row0 + ai * HALF + m * 16;
#pragma unroll
                for (int bj = 0; bj < 2; ++bj) { const f32x4 v0 = acc[ai][bj][m][0], v1 = acc[ai][bj][m][1];
                    u32x4 w; w.x = cvt_pk_bf16(v0[0], v0[1]); w.y = cvt_pk_bf16(v0[2], v0[3]); w.z = cvt_pk_bf16(v1[0], v1[1]); w.w = cvt_pk_bf16(v1[2], v1[3]);
                    bf16_t* p;
                    if (u.pn < 2) p = Q + (size_t)row * 512 + u.pn * 256 + bj * HALF + cl;
                    else if (u.pn == 2) p = (bj == 0 ? Kb : Vb) + (size_t)row * 128 + cl;
                    else { const int ch = (u.pn - 3) * 256 + bj * HALF + cl, g = ch >> 4, h0 = ch & 15;
                        p = As + ((size_t)(g * 2048 + (row >> 4)) * 384 + (row & 15) * 16 + h0); }
                    *(u32x4*)p = w; }
            }
    }
};
struct EpiSsmY {
    static constexpr bool PERM = true, AFTER_DRAIN = false;
    bf16_t* YG;
    __device__ __forceinline__ void operator()(const f32x4 (&acc)[2][2][4][2], const Unit& u, int wr, int wc, int fr, int fq) const {
        const int g = u.pn, n0 = (u.pm & 7) * BM + wr * 64 + fr;
#pragma unroll
        for (int ai = 0; ai < 2; ++ai)
#pragma unroll
            for (int m = 0; m < 4; ++m) {
                const int n = n0 + ai * HALF + m * 16;
#pragma unroll
                for (int bj = 0; bj < 2; ++bj) { const f32x4 v0 = acc[ai][bj][m][0], v1 = acc[ai][bj][m][1];
                    const int i = bj * 8 + wc * 2 + (fq >> 1), h0 = (fq & 1) * 8;
                    u32x4 w; w.x = cvt_pk_bf16(gelu_tanh_f(v0[0]), gelu_tanh_f(v0[1])); w.y = cvt_pk_bf16(gelu_tanh_f(v0[2]), gelu_tanh_f(v0[3]));
                    w.z = cvt_pk_bf16(gelu_tanh_f(v1[0]), gelu_tanh_f(v1[1])); w.w = cvt_pk_bf16(gelu_tanh_f(v1[2]), gelu_tanh_f(v1[3]));
                    *(u32x4*)(YG + (size_t)(n * 16 + i) * 512 + g * 16 + h0) = w; }
            }
    }
};
struct EpiGlu {
    static constexpr bool PERM = true, AFTER_DRAIN = false;
    const bf16_t* YG; bf16_t* O; const float* bias; float* ss;
    __device__ __forceinline__ void operator()(const f32x4 (&acc)[2][2][4][2], const Unit& u, int wr, int wc, int fr, int fq) const {
        const int row0 = u.pm * BM + wr * 64 + fr, col0 = u.pn * BM + wc * 32 + 8 * fq;
        f32x4 bv[2][2];
#pragma unroll
        for (int bj = 0; bj < 2; ++bj)
#pragma unroll
            for (int n = 0; n < 2; ++n) bv[bj][n] = *(const f32x4*)(bias + col0 + bj * HALF + 4 * n);
#pragma unroll
        for (int ai = 0; ai < 2; ++ai)
#pragma unroll
            for (int m = 0; m < 4; ++m) {
                const int row = row0 + ai * HALF + m * 16; float q = 0.f;
#pragma unroll
                for (int bj = 0; bj < 2; ++bj) { const f32x4 z0 = acc[ai][bj][m][0] + bv[bj][0], z1 = acc[ai][bj][m][1] + bv[bj][1];
                    const u32x4 yw = *(const u32x4*)(YG + (size_t)row * 512 + col0 + bj * HALF);
                    const float o0 = bf16_lo(yw.x) * sigmoid_f(z0[0]), o1 = bf16_hi(yw.x) * sigmoid_f(z0[1]), o2 = bf16_lo(yw.y) * sigmoid_f(z0[2]), o3 = bf16_hi(yw.y) * sigmoid_f(z0[3]);
                    const float o4 = bf16_lo(yw.z) * sigmoid_f(z1[0]), o5 = bf16_hi(yw.z) * sigmoid_f(z1[1]), o6 = bf16_lo(yw.w) * sigmoid_f(z1[2]), o7 = bf16_hi(yw.w) * sigmoid_f(z1[3]);
                    q += (o0 * o0 + o1 * o1) + (o2 * o2 + o3 * o3) + (o4 * o4 + o5 * o5) + (o6 * o6 + o7 * o7);
                    u32x4 w; w.x = cvt_pk_bf16(o0, o1); w.y = cvt_pk_bf16(o2, o3); w.z = cvt_pk_bf16(o4, o5); w.w = cvt_pk_bf16(o6, o7);
                    *(u32x4*)(O + (size_t)row * 512 + col0 + bj * HALF) = w; }
                q += __shfl_xor(q, 16); q += __shfl_xor(q, 32);
                if (fq == 0) ss[(size_t)row * 8 + u.pn * 4 + wc] = q;
            }
    }
};
struct SsmOrder {
    int G, c;
    __device__ __forceinline__ bool next(int i, Unit& u) const { const int L = i * G + c; if (L >= 256) return false; u.pm = L; u.pn = L >> 3; return true; }
    __device__ __forceinline__ void a_ready(const Unit&) const {}
    __device__ __forceinline__ void done(const Unit&) const {}
};
}
constexpr int NWAVES = 8, NTHR = 512;
constexpr int NB = 16, SEQ = 2048, DM = 1024, M = NB * SEQ, DFF = 2816, DIN = 1280, DATT = 512, DSSM = 512, NGRP = 32, NST = 64, NMOD = 9 * DM;
constexpr int KSS = 384;
constexpr float EPS = 1e-6f;
constexpr size_t MiB = 1u << 20;
constexpr size_t al256(size_t x) { return (x + 255) & ~(size_t)255; }
constexpr size_t WS_W1GU = 0;
constexpr size_t WS_W1D  = WS_W1GU + al256((size_t)2 * DFF * DM * 2);
constexpr size_t WS_W2GU = WS_W1D + al256((size_t)DM * DFF * 2);
constexpr size_t WS_W2D  = WS_W2GU + al256((size_t)2 * DFF * DM * 2);
constexpr size_t WS_WIN  = WS_W2D + al256((size_t)DM * DFF * 2);
constexpr size_t WS_WGLU = WS_WIN + al256((size_t)DIN * DM * 2);
constexpr size_t WS_WOUT = WS_WGLU + al256((size_t)DSSM * DSSM * 2);
constexpr size_t WS_TW   = WS_WOUT + al256((size_t)DM * DM * 2);
constexpr size_t WS_WS   = WS_TW + al256((size_t)NGRP * 256 * KSS * 2);
constexpr size_t WS_KT   = WS_WS + al256((size_t)NGRP * 128 * 256 * 2);
constexpr size_t WS_A16  = WS_KT + al256((size_t)NGRP * 16 * 256 * 4);
constexpr size_t WS_MOD  = WS_A16 + al256((size_t)2 * NGRP * NST * 4);
constexpr size_t WS_FSS  = WS_MOD + al256((size_t)NB * NMOD * 4);
constexpr size_t WS_SSS  = WS_FSS + al256((size_t)M * 16 * 4);
constexpr size_t WS_H    = al256(WS_SSS + (size_t)M * 8 * 4 + MiB);
constexpr size_t WS_F    = WS_H + (size_t)M * DM * 2;
constexpr size_t WS_SSMR = WS_F + (size_t)M * DM * 2;
constexpr size_t WS_ACT  = WS_SSMR + (size_t)M * DSSM * 2;
constexpr size_t WS_Q    = WS_ACT;
constexpr size_t WS_K    = WS_Q + (size_t)M * DATT * 2;
constexpr size_t WS_V    = WS_K + (size_t)M * 128 * 2;
constexpr size_t WS_AS   = WS_V + (size_t)M * 128 * 2;
constexpr size_t WS_S    = WS_AS + (size_t)NGRP * 2048 * KSS * 2;
constexpr size_t WS_YG   = WS_S + (size_t)NGRP * 2048 * 128 * 4;
constexpr size_t WS_MIXEND = WS_YG + (size_t)M * DSSM * 2;
constexpr size_t WS_END  = WS_ACT + (size_t)M * DFF * 2;
static_assert(WS_MIXEND <= WS_END, "mixer temporaries must fit inside ACT");
constexpr int LDS_BYTES = 147456;

#define GAS __attribute__((address_space(1)))
#define LAS __attribute__((address_space(3)))
typedef unsigned short bf16;
typedef unsigned v4u __attribute__((ext_vector_type(4)));
typedef unsigned v2u __attribute__((ext_vector_type(2)));
typedef float f32x4 __attribute__((ext_vector_type(4)));
typedef float f32x16 __attribute__((ext_vector_type(16)));
typedef short bf16x8 __attribute__((ext_vector_type(8)));
#define LDS_WAIT() asm volatile("s_waitcnt lgkmcnt(0)" ::: "memory")
__device__ __forceinline__ unsigned f2bf(float f) { unsigned u = __builtin_bit_cast(unsigned, f); return (u + 0x7fffu + ((u >> 16) & 1u)) >> 16; }
__device__ __forceinline__ unsigned pk2(float lo, float hi) { return pg8::cvt_pk_bf16(lo, hi); }
__device__ __forceinline__ float bflo(unsigned w) { return __uint_as_float(w << 16); }
__device__ __forceinline__ float bfhi(unsigned w) { return __uint_as_float(w & 0xffff0000u); }
__device__ __forceinline__ float wave_sum(float v) {
#pragma unroll
    for (int o = 1; o < 64; o <<= 1) v += __shfl_xor(v, o);
    return v;
}

struct Args { const float* in[31]; float* out; unsigned char* ws; };
enum { I_X = 0, I_C, I_WADA, I_BADA, I_GPRE1, I_GPOST1, I_W1G, I_W1U, I_W1D, I_GPREM, I_GPOSTM, I_WIN, I_SINKS, I_ARE, I_AIM, I_LSTEP, I_BRE, I_BIM, I_CRE, I_CIM, I_SSMD, I_WGLU, I_BGLU,
       I_GATT, I_GSSM, I_WOUT, I_GPRE2, I_GPOST2, I_W2G, I_W2U, I_W2D };

struct Frame {
    LAS unsigned char* lds; int tid, lane, wave, G;
};

template <int MAP> __device__ __forceinline__ void p0_transpose_item(const float* W, int K, int N, bf16* WT, LAS float* scr, int item, int lane) {
    const int nblk = N / 32, kb = item / nblk, nb = item % nblk, k0 = 64 * kb, n0 = 32 * nb;
#pragma unroll 8
    for (int i = 0; i < 32; ++i) { const int kk = 2 * i + (lane >> 5); scr[kk * 33 + (lane & 31)] = W[(size_t)(k0 + kk) * N + n0 + (lane & 31)]; }
    LDS_WAIT(); asm volatile("" ::: "memory");
    const int c = lane & 7;
    const int r0 = (MAP == 0) ? n0 : ((n0 >> 7) * 256 + (n0 & 127) + (MAP == 2 ? 128 : 0));
#pragma unroll
    for (int j = 0; j < 4; ++j) { const int n = (lane >> 3) + 8 * j; const LAS float* s = scr + (8 * c) * 33 + n;
        v4u o; o.x = pk2(s[0 * 33], s[1 * 33]); o.y = pk2(s[2 * 33], s[3 * 33]); o.z = pk2(s[4 * 33], s[5 * 33]); o.w = pk2(s[6 * 33], s[7 * 33]);
        *(GAS v4u*)(WT + (size_t)(r0 + n) * K + k0 + 8 * c) = o; }
    LDS_WAIT(); asm volatile("" ::: "memory");
}
__device__ __forceinline__ void p0_weights(Frame& F, const Args& a) {
    LAS float* scr = (LAS float*)(F.lds + F.wave * 16384);
    const int gw = blockIdx.x * NWAVES + F.wave, NGW = F.G * NWAVES;
    unsigned char* ws = a.ws;
    constexpr int I_GU = (DM / 64) * (DFF / 32), I_D = (DFF / 64) * (DM / 32), I_IN = (DM / 64) * (DIN / 32), I_GL = (DSSM / 64) * (DSSM / 32), I_O = (DM / 64) * (DM / 32);
    constexpr int NITEMS = 4 * I_GU + 2 * I_D + I_IN + I_GL + I_O;
    for (int it = gw; it < NITEMS; it += NGW) {
        int r = it;
        if (r < I_GU) { p0_transpose_item<1>(a.in[I_W1G], DM, DFF, (bf16*)(ws + WS_W1GU), scr, r, F.lane); continue; } r -= I_GU;
        if (r < I_GU) { p0_transpose_item<2>(a.in[I_W1U], DM, DFF, (bf16*)(ws + WS_W1GU), scr, r, F.lane); continue; } r -= I_GU;
        if (r < I_GU) { p0_transpose_item<1>(a.in[I_W2G], DM, DFF, (bf16*)(ws + WS_W2GU), scr, r, F.lane); continue; } r -= I_GU;
        if (r < I_GU) { p0_transpose_item<2>(a.in[I_W2U], DM, DFF, (bf16*)(ws + WS_W2GU), scr, r, F.lane); continue; } r -= I_GU;
        if (r < I_D) { p0_transpose_item<0>(a.in[I_W1D], DFF, DM, (bf16*)(ws + WS_W1D), scr, r, F.lane); continue; } r -= I_D;
        if (r < I_D) { p0_transpose_item<0>(a.in[I_W2D], DFF, DM, (bf16*)(ws + WS_W2D), scr, r, F.lane); continue; } r -= I_D;
        if (r < I_IN) { p0_transpose_item<0>(a.in[I_WIN], DM, DIN, (bf16*)(ws + WS_WIN), scr, r, F.lane); continue; } r -= I_IN;
        if (r < I_GL) { p0_transpose_item<0>(a.in[I_WGLU], DSSM, DSSM, (bf16*)(ws + WS_WGLU), scr, r, F.lane); continue; } r -= I_GL;
        p0_transpose_item<0>(a.in[I_WOUT], DM, DM, (bf16*)(ws + WS_WOUT), scr, r, F.lane);
    }
}
__device__ __forceinline__ void p0_mod(Frame& F, const Args& a) {
    LAS float* cact = (LAS float*)F.lds;
    LAS float* red = (LAS float*)(F.lds + 65536);
    const float* c = a.in[I_C]; const float* W = a.in[I_WADA]; const float* bias = a.in[I_BADA]; float* mod = (float*)(a.ws + WS_MOD);
    for (int i = F.tid; i < NB * DM; i += NTHR) { const int b = i >> 10, k = i & 1023; const float v = c[i]; cact[k * 16 + b] = v / (1.0f + __expf(-v)); }
    __syncthreads();
    for (int tile = blockIdx.x; tile < NMOD / 32; tile += F.G) {
        const int n0 = tile * 32, nl = F.lane & 31, kh = F.lane >> 5;
        float acc[16];
#pragma unroll
        for (int b = 0; b < 16; ++b) acc[b] = 0.f;
        const float* wp = W + (size_t)(F.wave * 128 + kh) * NMOD + n0 + nl;
#pragma unroll 8
        for (int kk = 0; kk < 64; ++kk) {
            const float w = wp[(size_t)kk * 2 * NMOD];
            const LAS f32x4* cp = (const LAS f32x4*)(cact + (F.wave * 128 + kk * 2 + kh) * 16);
            const f32x4 c0 = cp[0], c1 = cp[1], c2 = cp[2], c3 = cp[3];
            acc[0] += c0[0] * w; acc[1] += c0[1] * w; acc[2] += c0[2] * w; acc[3] += c0[3] * w;
            acc[4] += c1[0] * w; acc[5] += c1[1] * w; acc[6] += c1[2] * w; acc[7] += c1[3] * w;
            acc[8] += c2[0] * w; acc[9] += c2[1] * w; acc[10] += c2[2] * w; acc[11] += c2[3] * w;
            acc[12] += c3[0] * w; acc[13] += c3[1] * w; acc[14] += c3[2] * w; acc[15] += c3[3] * w;
        }
#pragma unroll
        for (int b = 0; b < 16; ++b) acc[b] += __shfl_xor(acc[b], 32);
        if (kh == 0) {
#pragma unroll
            for (int b = 0; b < 16; ++b) red[(F.wave * 16 + b) * 32 + nl] = acc[b];
        }
        __syncthreads();
        { const int b = F.tid >> 5, n = F.tid & 31; float s = bias[n0 + n];
#pragma unroll
          for (int w = 0; w < 8; ++w) s += red[(w * 16 + b) * 32 + n];
          mod[(size_t)b * NMOD + n0 + n] = s; }
        __syncthreads();
    }
}
__device__ __forceinline__ void p0_ssm(Frame& F, const Args& a) {
    LAS float* pwr = (LAS float*)F.lds;
    LAS float* pwi = pwr + 17 * 64;
    LAS float* cfr = pwi + 17 * 64;
    LAS float* cfi = cfr + 64;
    const float* a_re = a.in[I_ARE]; const float* a_im = a.in[I_AIM]; const float* lstep = a.in[I_LSTEP];
    const float* b_re = a.in[I_BRE]; const float* b_im = a.in[I_BIM]; const float* c_re = a.in[I_CRE]; const float* c_im = a.in[I_CIM]; const float* dsk = a.in[I_SSMD];
    bf16* Tw = (bf16*)(a.ws + WS_TW); bf16* WS = (bf16*)(a.ws + WS_WS); float* Kt = (float*)(a.ws + WS_KT); float* A16 = (float*)(a.ws + WS_A16);
    for (int wi = blockIdx.x; wi < 256; wi += F.G) {
        const int g = wi >> 3, tp = wi & 7;
        __syncthreads();
        const float dt = expf(lstep[g]);
        for (int i = F.tid; i < 17 * 64; i += NTHR) { const int tau = i >> 6, p = i & 63; const float are = a_re[g * 64 + p], aim = a_im[g * 64 + p];
            const float mag = expf(are * dt * (float)tau); float s, c; sincosf(aim * dt * (float)tau, &s, &c); pwr[i] = mag * c; pwi[i] = mag * s; }
        if (F.tid < 64) { const int p = F.tid; const float are = a_re[g * 64 + p], aim = a_im[g * 64 + p];
            const float mag = expf(are * dt); float s, c; sincosf(aim * dt, &s, &c); const float lr = mag * c - 1.0f, li = mag * s, den = are * are + aim * aim;
            cfr[p] = (lr * are + li * aim) / den; cfi[p] = (li * are - lr * aim) / den; }
        __syncthreads();
        {
            const int tau = 2 * tp + (F.tid >> 8), h = (F.tid >> 4) & 15, hp = F.tid & 15; float acc = 0.f;
            for (int p = 0; p < 64; ++p) {
                const float cr = c_re[(g * 16 + h) * 64 + p], ci = c_im[(g * 16 + h) * 64 + p], br = b_re[(g * 64 + p) * 16 + hp], bi = b_im[(g * 64 + p) * 16 + hp];
                const float bbr = cfr[p] * br - cfi[p] * bi, bbi = cfr[p] * bi + cfi[p] * br;
                const float pr = pwr[tau * 64 + p], pi = pwi[tau * 64 + p];
                const float wr_ = pr * bbr - pi * bbi, wi_ = pr * bbi + pi * bbr;
                acc += cr * wr_ - ci * wi_; }
            if (tau == 0 && h == hp) acc += dsk[g * 16 + h];
            Kt[((g * 16 + tau) * 16 + h) * 16 + hp] = acc;
        }
        for (int e = F.tid; e < 2048; e += NTHR) {
            const int i = 2 * tp + (e >> 10), h = (e >> 6) & 15, p = e & 63;
            const float cr = c_re[(g * 16 + h) * 64 + p], ci = c_im[(g * 16 + h) * 64 + p], pr = pwr[(i + 1) * 64 + p], pi = pwi[(i + 1) * 64 + p];
            bf16* row = Tw + (size_t)(g * 256 + i * 16 + h) * KSS;
            row[256 + p] = (bf16)f2bf(cr * pr - ci * pi); row[320 + p] = (bf16)f2bf(-(cr * pi + ci * pr)); }
        for (int e = F.tid; e < 2048; e += NTHR) {
            const int j = 2 * tp + (e >> 10), p = (e >> 4) & 63, hp = e & 15;
            const float br = b_re[(g * 64 + p) * 16 + hp], bi = b_im[(g * 64 + p) * 16 + hp];
            const float bbr = cfr[p] * br - cfi[p] * bi, bbi = cfr[p] * bi + cfi[p] * br;
            const float pr = pwr[(15 - j) * 64 + p], pi = pwi[(15 - j) * 64 + p];
            WS[(size_t)(g * 128 + p) * 256 + j * 16 + hp] = (bf16)f2bf(pr * bbr - pi * bbi);
            WS[(size_t)(g * 128 + 64 + p) * 256 + j * 16 + hp] = (bf16)f2bf(pr * bbi + pi * bbr); }
        if (tp == 0 && F.tid < 64) { A16[g * 64 + F.tid] = pwr[16 * 64 + F.tid]; A16[NGRP * 64 + g * 64 + F.tid] = pwi[16 * 64 + F.tid]; }
    }
    __syncthreads();
}
__device__ __forceinline__ void p1_toeplitz(Frame& F, const Args& a) {
    const float* Kt = (const float*)(a.ws + WS_KT); bf16* Tw = (bf16*)(a.ws + WS_TW);
    for (int it = blockIdx.x * NTHR + F.tid; it < NGRP * 256 * 32; it += F.G * NTHR) {
        const int g = it >> 13, r = (it >> 5) & 255, jc = it & 31, i = r >> 4, h = r & 15, j = jc >> 1, hp0 = (jc & 1) * 8;
        v4u o = (v4u){0u, 0u, 0u, 0u};
        if (j <= i) { const float* k = Kt + ((g * 16 + (i - j)) * 16 + h) * 16 + hp0; const f32x4 k0 = *(const f32x4*)k, k1 = *(const f32x4*)(k + 4);
            o.x = pk2(k0[0], k0[1]); o.y = pk2(k0[2], k0[3]); o.z = pk2(k1[0], k1[1]); o.w = pk2(k1[2], k1[3]); }
        *(v4u*)(Tw + (size_t)(g * 256 + r) * KSS + j * 16 + hp0) = o;
    }
}
__device__ __forceinline__ void rows_norm_mod(Frame& F, const float* x, const float* g, const float* sh, const float* sc, bf16* H) {
    const int gw = blockIdx.x * NWAVES + F.wave, NGW = F.G * NWAVES;
    for (int m = gw; m < M; m += NGW) {
        const int b = m >> 11; const f32x4* xr = (const f32x4*)(x + (size_t)m * DM) + F.lane;
        f32x4 v[4]; float s = 0.f;
#pragma unroll
        for (int j = 0; j < 4; ++j) { v[j] = xr[64 * j]; s += (v[j][0] * v[j][0] + v[j][1] * v[j][1]) + (v[j][2] * v[j][2] + v[j][3] * v[j][3]); }
        const float rstd = 1.0f / sqrtf(wave_sum(s) * (1.0f / DM) + EPS);
        v2u* o8 = (v2u*)(H + (size_t)m * DM) + F.lane;
#pragma unroll
        for (int j = 0; j < 4; ++j) { const int col = 4 * F.lane + 256 * j;
            const f32x4 g4 = *(const f32x4*)(g + col), s4 = *(const f32x4*)(sc + (size_t)b * NMOD + col), h4 = *(const f32x4*)(sh + (size_t)b * NMOD + col);
            const f32x4 o = v[j] * rstd * g4 * (1.0f + s4) + h4;
            o8[64 * j] = (v2u){pk2(o[0], o[1]), pk2(o[2], o[3])}; }
    }
}
template <bool NORM> __device__ __forceinline__ void rows_residual(Frame& F, const float* xin, float* xout, const bf16* f, const float* fss, float coef, const float* ga, const float* gpost,
                                                                    const float* gpre, const float* sh, const float* sc, bf16* H) {
    const int gw = blockIdx.x * NWAVES + F.wave, NGW = F.G * NWAVES;
    for (int m = gw; m < M; m += NGW) {
        const int b = m >> 11; const f32x4* xr = (const f32x4*)(xin + (size_t)m * DM) + F.lane; const v2u* fr = (const v2u*)(f + (size_t)m * DM) + F.lane;
        float q = (F.lane < 16) ? fss[(size_t)m * 16 + F.lane] : 0.f; q = wave_sum(q);
        const float rf = coef / sqrtf(q * (1.0f / DM) + EPS);
        f32x4 v[4]; float s = 0.f;
#pragma unroll
        for (int j = 0; j < 4; ++j) { const int col = 4 * F.lane + 256 * j; const f32x4 xv = xr[64 * j]; const v2u fw = fr[64 * j];
            const f32x4 ga4 = *(const f32x4*)(ga + (size_t)b * NMOD + col), gp4 = *(const f32x4*)(gpost + col);
            const f32x4 fv = (f32x4){bflo(fw.x), bfhi(fw.x), bflo(fw.y), bfhi(fw.y)};
            v[j] = xv + ga4 * gp4 * fv * rf;
            s += (v[j][0] * v[j][0] + v[j][1] * v[j][1]) + (v[j][2] * v[j][2] + v[j][3] * v[j][3]); }
        f32x4* xo = (f32x4*)(xout + (size_t)m * DM) + F.lane;
#pragma unroll
        for (int j = 0; j < 4; ++j) xo[64 * j] = v[j];
        if (NORM) {
            const float rstd = 1.0f / sqrtf(wave_sum(s) * (1.0f / DM) + EPS);
            v2u* o8 = (v2u*)(H + (size_t)m * DM) + F.lane;
#pragma unroll
            for (int j = 0; j < 4; ++j) { const int col = 4 * F.lane + 256 * j;
                const f32x4 g4 = *(const f32x4*)(gpre + col), s4 = *(const f32x4*)(sc + (size_t)b * NMOD + col), h4 = *(const f32x4*)(sh + (size_t)b * NMOD + col);
                const f32x4 o = v[j] * rstd * g4 * (1.0f + s4) + h4;
                o8[64 * j] = (v2u){pk2(o[0], o[1]), pk2(o[2], o[3])}; }
        }
    }
}
__device__ __forceinline__ void rows_ssm_norm(Frame& F, const bf16* sr, const float* sss, const float* g, bf16* MX) {
    const int gw = blockIdx.x * NWAVES + F.wave, NGW = F.G * NWAVES;
    for (int m = gw; m < M; m += NGW) {
        float q = (F.lane < 8) ? sss[(size_t)m * 8 + F.lane] : 0.f; q = wave_sum(q);
        const float r = 1.0f / sqrtf(q * (1.0f / DSSM) + EPS);
        const v4u w = *((const v4u*)(sr + (size_t)m * DSSM) + F.lane);
        const f32x4 g0 = *(const f32x4*)(g + 8 * F.lane), g1 = *(const f32x4*)(g + 8 * F.lane + 4);
        v4u o; o.x = pk2(bflo(w.x) * r * g0[0], bfhi(w.x) * r * g0[1]); o.y = pk2(bflo(w.y) * r * g0[2], bfhi(w.y) * r * g0[3]);
        o.z = pk2(bflo(w.z) * r * g1[0], bfhi(w.z) * r * g1[1]); o.w = pk2(bflo(w.w) * r * g1[2], bfhi(w.w) * r * g1[3]);
        *((v4u*)(MX + (size_t)m * DM + DATT) + F.lane) = o;
    }
}
__device__ __forceinline__ void ssm_state_gemm(Frame& F, const Args& a) {
    const bf16* As = (const bf16*)(a.ws + WS_AS); const bf16* WS = (const bf16*)(a.ws + WS_WS); float* S = (float*)(a.ws + WS_S);
    const int r = F.lane & 31, h = F.lane >> 5;
    for (int wu = F.wave * F.G + blockIdx.x; wu < NGRP * 64; wu += F.G * NWAVES) {
        const int g = wu >> 6, n0 = (wu & 63) * 32;
        f32x16 acc[4];
#pragma unroll
        for (int st = 0; st < 4; ++st)
#pragma unroll
            for (int e = 0; e < 16; ++e) acc[st][e] = 0.f;
        const bf16* ap = As + (size_t)(g * 2048 + n0 + r) * KSS + 8 * h;
        const bf16* bp = WS + (size_t)(g * 128 + r) * 256 + 8 * h;
#pragma unroll 4
        for (int kk = 0; kk < 16; ++kk) {
            const bf16x8 af = *(const bf16x8*)(ap + kk * 16);
#pragma unroll
            for (int st = 0; st < 4; ++st) { const bf16x8 bf = *(const bf16x8*)(bp + (size_t)st * 32 * 256 + kk * 16);
                acc[st] = __builtin_amdgcn_mfma_f32_32x32x16_bf16(af, bf, acc[st], 0, 0, 0); }
        }
#pragma unroll
        for (int st = 0; st < 4; ++st)
#pragma unroll
            for (int e = 0; e < 16; ++e) { const int row = (e & 3) + 8 * (e >> 2) + 4 * h;
                S[(size_t)(g * 2048 + n0 + row) * 128 + st * 32 + r] = acc[st][e]; }
    }
}
__device__ __forceinline__ void ssm_scan(Frame& F, const Args& a) {
    bf16* As = (bf16*)(a.ws + WS_AS); const float* S = (const float*)(a.ws + WS_S); const float* A16 = (const float*)(a.ws + WS_A16);
    for (int wu = F.wave * F.G + blockIdx.x; wu < NB * NGRP; wu += F.G * NWAVES) {
        const int b = wu >> 5, g = wu & 31, p = F.lane;
        const float ar = A16[g * 64 + p], ai = A16[NGRP * 64 + g * 64 + p];
        float xr = 0.f, xi = 0.f;
        const float* sp = S + (size_t)(g * 2048 + b * 128) * 128 + p; bf16* xp = As + (size_t)(g * 2048 + b * 128) * KSS + 256 + p;
        for (int c0 = 0; c0 < 128; c0 += 16) {
            float sr[16], si[16];
#pragma unroll
            for (int j = 0; j < 16; ++j) { sr[j] = sp[(size_t)(c0 + j) * 128]; si[j] = sp[(size_t)(c0 + j) * 128 + 64]; }
#pragma unroll
            for (int j = 0; j < 16; ++j) {
                xp[(size_t)(c0 + j) * KSS] = (bf16)f2bf(xr); xp[(size_t)(c0 + j) * KSS + 64] = (bf16)f2bf(xi);
                const float nr = ar * xr - ai * xi + sr[j], ni = ar * xi + ai * xr + si[j]; xr = nr; xi = ni; }
        }
    }
}
constexpr int AT_K = 0, AT_VT = 65536, AT_VTH = 33280  , AT_X = AT_VT + 2 * AT_VTH  ;
__device__ __forceinline__ void attn_phase(Frame& F, const Args& a) {
    const bf16* Qg = (const bf16*)(a.ws + WS_Q); const bf16* Kg = (const bf16*)(a.ws + WS_K); const bf16* Vg = (const bf16*)(a.ws + WS_V); bf16* MX = (bf16*)(a.ws + WS_H);
    const float* sinks = a.in[I_SINKS]; const float* gat = a.in[I_GATT];
    const int r = F.lane & 31, h = F.lane >> 5, hq = F.wave, kvh = hq >> 2;
    const float slope2 = exp2f(-(float)(hq + 1)) * pg8::LOG2E, sink2 = sinks[hq] * pg8::LOG2E, qscale = 0.125f * pg8::LOG2E;
    LAS float* xch = (LAS float*)(F.lds + AT_X);
    for (int unit = blockIdx.x; unit < NB * (SEQ / 128); unit += F.G) {
        const int b = unit >> 4, nb = unit & 15; const size_t tok0 = (size_t)b * SEQ + (size_t)nb * 128;
        __syncthreads();
#pragma unroll 2
        for (int it = 0; it < 8; ++it) {
            const int id = it * NTHR + F.tid, kj = id >> 4, cc = id & 15, kh = cc >> 3, c = cc & 7;
            v4u kv = (v4u){0u, 0u, 0u, 0u}, vv = (v4u){0u, 0u, 0u, 0u};
            if (nb > 0 || kj >= 128) { const size_t t = tok0 - 128 + kj; kv = *(const v4u*)(Kg + t * 128 + cc * 8); vv = *(const v4u*)(Vg + t * 128 + cc * 8); }
            *(LAS v4u*)(F.lds + AT_K + kh * 32768 + kj * 128 + ((c ^ (kj & 7)) << 4)) = kv;
            LAS unsigned short* vt = (LAS unsigned short*)(F.lds + AT_VT + kh * AT_VTH + (c * 8) * 520) + kj;
            vt[0 * 260] = (unsigned short)(vv.x & 0xffffu); vt[1 * 260] = (unsigned short)(vv.x >> 16); vt[2 * 260] = (unsigned short)(vv.y & 0xffffu); vt[3 * 260] = (unsigned short)(vv.y >> 16);
            vt[4 * 260] = (unsigned short)(vv.z & 0xffffu); vt[5 * 260] = (unsigned short)(vv.z >> 16); vt[6 * 260] = (unsigned short)(vv.w & 0xffffu); vt[7 * 260] = (unsigned short)(vv.w >> 16);
        }
        __syncthreads();
        const LAS unsigned char* Kl = F.lds + AT_K + kvh * 32768; const LAS unsigned char* Vl = F.lds + AT_VT + kvh * AT_VTH;
#pragma unroll 1
        for (int qt = 0; qt < 4; ++qt) {
            bf16x8 qf[4];
            const bf16* qp = Qg + (tok0 + 32 * qt + r) * DATT + hq * 64 + 8 * h;
#pragma unroll
            for (int s = 0; s < 4; ++s) qf[s] = *(const bf16x8*)(qp + 16 * s);
            f32x16 sc[5];
#pragma unroll
            for (int t5 = 0; t5 < 5; ++t5) {
#pragma unroll
                for (int e = 0; e < 16; ++e) sc[t5][e] = 0.f;
                const int key = 32 * (qt + t5) + r;
#pragma unroll
                for (int s = 0; s < 4; ++s) { const bf16x8 kf = *(const LAS bf16x8*)(Kl + key * 128 + (((2 * s + h) ^ (key & 7)) << 4));
                    sc[t5] = __builtin_amdgcn_mfma_f32_32x32x16_bf16(kf, qf[s], sc[t5], 0, 0, 0); }
            }
            float mx = sink2;
#pragma unroll
            for (int t5 = 0; t5 < 5; ++t5)
#pragma unroll
                for (int e = 0; e < 16; ++e) { const int koff = (e & 3) + 8 * (e >> 2) + 4 * h; const int dist = r + 128 - 32 * t5 - koff;
                    bool valid = (dist >= 0) && (dist < 128) && (nb > 0 || (qt + t5) >= 4);
                    const float v = valid ? (sc[t5][e] * qscale - slope2 * (float)dist) : -1e30f; sc[t5][e] = v; mx = fmaxf(mx, v); }
            mx = fmaxf(mx, __shfl_xor(mx, 32));
            float sum = 0.f;
#pragma unroll
            for (int t5 = 0; t5 < 5; ++t5)
#pragma unroll
                for (int e = 0; e < 16; ++e) { const float pv = __builtin_amdgcn_exp2f(sc[t5][e] - mx); sc[t5][e] = pv; sum += pv; }
            sum += __shfl_xor(sum, 32);
            const float inv = 1.0f / (sum + __builtin_amdgcn_exp2f(sink2 - mx));
            f32x16 o[2];
#pragma unroll
            for (int dt = 0; dt < 2; ++dt)
#pragma unroll
                for (int e = 0; e < 16; ++e) o[dt][e] = 0.f;
#pragma unroll
            for (int t5 = 0; t5 < 5; ++t5)
#pragma unroll
                for (int s2 = 0; s2 < 2; ++s2) {
                    v4u pw; pw.x = pk2(sc[t5][8 * s2 + 0], sc[t5][8 * s2 + 1]); pw.y = pk2(sc[t5][8 * s2 + 2], sc[t5][8 * s2 + 3]);
                    pw.z = pk2(sc[t5][8 * s2 + 4], sc[t5][8 * s2 + 5]); pw.w = pk2(sc[t5][8 * s2 + 6], sc[t5][8 * s2 + 7]);
                    const bf16x8 pf = __builtin_bit_cast(bf16x8, pw);
                    const int key0 = 32 * (qt + t5) + 16 * s2 + 4 * h;
#pragma unroll
                    for (int dt = 0; dt < 2; ++dt) { const LAS unsigned char* vp = Vl + (dt * 32 + r) * 520 + key0 * 2;
                        const v2u lo = *(const LAS v2u*)vp, hi = *(const LAS v2u*)(vp + 16);
                        const v4u vw = (v4u){lo.x, lo.y, hi.x, hi.y};
                        o[dt] = __builtin_amdgcn_mfma_f32_32x32x16_bf16(__builtin_bit_cast(bf16x8, vw), pf, o[dt], 0, 0, 0); }
                }
            float ssq = 0.f;
#pragma unroll
            for (int dt = 0; dt < 2; ++dt)
#pragma unroll
                for (int e = 0; e < 16; ++e) { o[dt][e] *= inv; ssq += o[dt][e] * o[dt][e]; }
            ssq += __shfl_xor(ssq, 32);
            LAS float* xb = xch + (qt & 1) * 256;
            if (h == 0) xb[r * 8 + hq] = ssq;
            __syncthreads();
            float tot = 0.f;
#pragma unroll
            for (int w = 0; w < 8; ++w) tot += xb[r * 8 + w];
            const float rn = 1.0f / sqrtf(tot * (1.0f / DATT) + EPS);
            bf16* op = MX + (tok0 + 32 * qt + r) * DM + hq * 64 + 4 * h;
#pragma unroll
            for (int dt = 0; dt < 2; ++dt)
#pragma unroll
                for (int k4 = 0; k4 < 4; ++k4) { const f32x4 g4 = *(const f32x4*)(gat + hq * 64 + dt * 32 + 8 * k4 + 4 * h);
                    const v2u w = (v2u){pk2(o[dt][4 * k4 + 0] * rn * g4[0], o[dt][4 * k4 + 1] * rn * g4[1]), pk2(o[dt][4 * k4 + 2] * rn * g4[2], o[dt][4 * k4 + 3] * rn * g4[3])};
                    *(v2u*)(op + dt * 32 + 8 * k4) = w; }
        }
    }
    __syncthreads();
}
#ifndef PHMASK
#define PHMASK 0xFFFFFu
#endif
__global__ void __launch_bounds__(NTHR, 2) fwd_megakernel(Args args) {
    extern __shared__ __attribute__((aligned(16))) unsigned char lds_raw[];
    cg::grid_group grid = cg::this_grid();
    Frame F; F.lds = (LAS unsigned char*)lds_raw; F.tid = threadIdx.x; F.lane = F.tid & 63; F.wave = __builtin_amdgcn_readfirstlane(F.tid >> 6); F.G = gridDim.x;
    unsigned char* ws = args.ws;
    const float* mod = (const float*)(ws + WS_MOD);
    bf16* H = (bf16*)(ws + WS_H); bf16* ACT = (bf16*)(ws + WS_ACT); bf16* Fb = (bf16*)(ws + WS_F); float* FSS = (float*)(ws + WS_FSS); float* SSS = (float*)(ws + WS_SSS);
    const float* x = args.in[I_X]; float* out = args.out;

    if (PHMASK & (1u << 0)) {
    p0_mod(F, args); __syncthreads();
    p0_ssm(F, args); __syncthreads();
    p0_weights(F, args);
    }
    grid.sync();
    if (PHMASK & (1u << 1)) {
    rows_norm_mod(F, x, args.in[I_GPRE1], mod + 0 * DM, mod + 1 * DM, H);
    p1_toeplitz(F, args);
    }
    grid.sync();
    if (PHMASK & (1u << 2)) {
    { pg8::Gemm g{H, (const bf16*)(ws + WS_W1GU), M, 2 * DFF, DM}; pg8::StaticOrder S; S.init(M, 2 * DFF, F.G, (int)blockIdx.x);
      pg8::EpiSwiGLU E{ACT, DFF}; pg8::gemm_phase<pg8::EpiSwiGLU, pg8::StaticOrder, true, true>(F.lds, g, S, E); }
    }
    grid.sync();
    if (PHMASK & (1u << 3)) {
    { pg8::Gemm g{ACT, (const bf16*)(ws + WS_W1D), M, DM, DFF}; pg8::StaticOrder S; S.init(M, DM, F.G, (int)blockIdx.x);
      pg8::EpiBf16SS E{Fb, DM, FSS, 16}; pg8::gemm_phase<pg8::EpiBf16SS, pg8::StaticOrder, true, true>(F.lds, g, S, E); }
    }
    grid.sync();
    if (PHMASK & (1u << 4)) {
    rows_residual<true>(F, x, out, Fb, FSS, 0.5f, mod + 2 * DM, args.in[I_GPOST1], args.in[I_GPREM], mod + 3 * DM, mod + 4 * DM, H);
    }
    grid.sync();
    if (PHMASK & (1u << 5)) {
    { pg8::Gemm g{H, (const bf16*)(ws + WS_WIN), M, DIN, DM}; pg8::StaticOrder S; S.init(M, DIN, F.G, (int)blockIdx.x);
      pg8::EpiWin E{(bf16*)(ws + WS_Q), (bf16*)(ws + WS_K), (bf16*)(ws + WS_V), (bf16*)(ws + WS_AS)}; pg8::gemm_phase<pg8::EpiWin, pg8::StaticOrder, true, true>(F.lds, g, S, E); }
    }
    grid.sync();
    if (PHMASK & (1u << 6)) {
    ssm_state_gemm(F, args);
    attn_phase(F, args);
    }
    grid.sync();
    if (PHMASK & (1u << 7)) {
    ssm_scan(F, args);
    }
    grid.sync();
    if (PHMASK & (1u << 8)) {
    { pg8::Gemm g{(const bf16*)(ws + WS_AS), (const bf16*)(ws + WS_TW), NGRP * 2048, NGRP * 256, KSS}; pg8::SsmOrder S{F.G, (int)blockIdx.x};
      pg8::EpiSsmY E{(bf16*)(ws + WS_YG)}; pg8::gemm_phase<pg8::EpiSsmY, pg8::SsmOrder, true, true>(F.lds, g, S, E); }
    }
    grid.sync();
    if (PHMASK & (1u << 9)) {
    { pg8::Gemm g{(const bf16*)(ws + WS_YG), (const bf16*)(ws + WS_WGLU), M, DSSM, DSSM}; pg8::StaticOrder S; S.init(M, DSSM, F.G, (int)blockIdx.x);
      pg8::EpiGlu E{(const bf16*)(ws + WS_YG), (bf16*)(ws + WS_SSMR), args.in[I_BGLU], SSS}; pg8::gemm_phase<pg8::EpiGlu, pg8::StaticOrder, true, true>(F.lds, g, S, E); }
    }
    grid.sync();
    if (PHMASK & (1u << 10)) {
    rows_ssm_norm(F, (const bf16*)(ws + WS_SSMR), SSS, args.in[I_GSSM], H);
    }
    grid.sync();
    if (PHMASK & (1u << 11)) {
    { pg8::Gemm g{H, (const bf16*)(ws + WS_WOUT), M, DM, DM}; pg8::StaticOrder S; S.init(M, DM, F.G, (int)blockIdx.x);
      pg8::EpiBf16SS E{Fb, DM, FSS, 16}; pg8::gemm_phase<pg8::EpiBf16SS, pg8::StaticOrder, true, true>(F.lds, g, S, E); }
    }
    grid.sync();
    if (PHMASK & (1u << 12)) {
    rows_residual<true>(F, out, out, Fb, FSS, 1.0f, mod + 5 * DM, args.in[I_GPOSTM], args.in[I_GPRE2], mod + 6 * DM, mod + 7 * DM, H);
    }
    grid.sync();
    if (PHMASK & (1u << 14)) {
    { pg8::Gemm g{H, (const bf16*)(ws + WS_W2GU), M, 2 * DFF, DM}; pg8::StaticOrder S; S.init(M, 2 * DFF, F.G, (int)blockIdx.x);
      pg8::EpiSwiGLU E{ACT, DFF}; pg8::gemm_phase<pg8::EpiSwiGLU, pg8::StaticOrder, true, true>(F.lds, g, S, E); }
    }
    grid.sync();
    if (PHMASK & (1u << 15)) {
    { pg8::Gemm g{ACT, (const bf16*)(ws + WS_W2D), M, DM, DFF}; pg8::StaticOrder S; S.init(M, DM, F.G, (int)blockIdx.x);
      pg8::EpiBf16SS E{Fb, DM, FSS, 16}; pg8::gemm_phase<pg8::EpiBf16SS, pg8::StaticOrder, true, true>(F.lds, g, S, E); }
    }
    grid.sync();
    if (PHMASK & (1u << 13)) {
    rows_residual<false>(F, out, out, Fb, FSS, 0.5f, mod + 8 * DM, args.in[I_GPOST2], nullptr, nullptr, nullptr, nullptr);
    }
}

extern "C" void kernel_launch(void* const* d_in, const int* in_sizes, int n_in, void* d_out, int out_size, void* d_ws, size_t ws_size, hipStream_t stream) {
    static int grid = 0;
    if (grid == 0) {
        if (n_in != 31 || in_sizes[0] != M * DM || out_size != M * DM || ws_size < WS_END) {
            fprintf(stderr, "kernel_launch: unexpected shapes (n_in %d, in0 %d, out %d, ws %zu, need %zu); nothing launched\n", n_in, n_in > 0 ? in_sizes[0] : -1, out_size, ws_size, (size_t)WS_END); grid = -1; return; }
        int dev = 0, cus = 0, per_cu = 0;
        if (hipGetDevice(&dev) != hipSuccess || hipDeviceGetAttribute(&cus, hipDeviceAttributeMultiprocessorCount, dev) != hipSuccess) { fprintf(stderr, "kernel_launch: device query failed\n"); grid = -1; return; }
        if (hipFuncSetAttribute((const void*)fwd_megakernel, hipFuncAttributeMaxDynamicSharedMemorySize, LDS_BYTES) != hipSuccess) { fprintf(stderr, "kernel_launch: hipFuncSetAttribute failed\n"); grid = -1; return; }
        if (hipOccupancyMaxActiveBlocksPerMultiprocessor(&per_cu, (const void*)fwd_megakernel, NTHR, LDS_BYTES) != hipSuccess || per_cu < 1) { fprintf(stderr, "kernel_launch: occupancy query says %d blocks per CU\n", per_cu); per_cu = 1; }
        (void)hipGetLastError();
        grid = cus;
        fprintf(stderr, "kernel_launch: %d CUs, occupancy %d/CU, grid %d\n", cus, per_cu, grid);
    }
    if (grid < 0) return;
    Args a{};
    for (int i = 0; i < 31; ++i) a.in[i] = (const float*)d_in[i];
    a.out = (float*)d_out; a.ws = (unsigned char*)d_ws;
    void* params[] = {&a};
    hipError_t e = hipLaunchCooperativeKernel((const void*)fwd_megakernel, dim3(grid), dim3(NTHR), params, LDS_BYTES, stream);
    if (e != hipSuccess) fprintf(stderr, "kernel_launch: cooperative launch failed: %s (grid %d)\n", hipGetErrorString(e), grid);
}
```

```cpp
#include <hip/hip_runtime.h>
#include <cstdio>
#include <cstdint>
namespace pg8 {
#define PG8_LAS __attribute__((address_space(3)))
typedef unsigned short bf16_t;
typedef short bf16x8 __attribute__((ext_vector_type(8)));
typedef float f32x4 __attribute__((ext_vector_type(4)));
typedef unsigned u32x4 __attribute__((ext_vector_type(4)));
constexpr int BM = 256, BK = 64, HALF = 128, HTB = HALF * BK * 2  , STAGE_BYTES = 8 * HTB, NXCD = 8, WGM = 8;

__host__ __device__ __forceinline__ int lds_byte(int r, int c) { const int st = (r >> 4) * 2 + (c >> 5), rr = r & 15, cc = c & 31, ob = rr * 64 + cc * 2; return st * 1024 + (ob ^ (((ob >> 9) & 1) << 5)); }
__host__ __device__ __forceinline__ void stage_rc(int b, int& R, int& C) { const int st = b / 1024, sb = b % 1024, swz = sb ^ (((sb >> 9) & 1) << 5); R = (st >> 1) * 16 + swz / 64; C = (st & 1) * 32 + (swz % 64) / 2; }
__host__ __device__ __forceinline__ int perm32(int rho) { const int n = rho >> 4, i = rho & 15; return 8 * (i >> 2) + 4 * n + (i & 3); }

struct Unit { int pm, pn; };
struct Gemm { const bf16_t* A; const bf16_t* Bt; int M, N, K; int blkA = 0, blkB = 0; };

struct StaticOrder {
    int nM, nN, nwg, G, c, wgm, rev;
    __host__ __device__ void init(int M, int N, int G_, int c_, int wgm_ = WGM, int rev_ = 0) { nM = M / BM; nN = N / BM; nwg = nM * nN; G = G_; c = c_; wgm = wgm_; rev = rev_; }
    __host__ __device__ bool next(int i, Unit& u) const {
        if ((long)i * G + c >= nwg) return false;
        const long L = (long)(rev ? (nwg / G - 1 - i) : i) * G + c;
        int wgid = (int)L; { const int q = nwg / NXCD, r = nwg % NXCD, xcd = wgid % NXCD, off = wgid / NXCD; wgid = (xcd < r ? xcd * (q + 1) : r * (q + 1) + (xcd - r) * q) + off; }
        const int nig = wgm * nN, gid = wgid / nig, fm = gid * wgm, gsz = (nM - fm) < wgm ? (nM - fm) : wgm;
        u.pm = fm + ((wgid % nig) % gsz); u.pn = (wgid % nig) / gsz; return true;
    }
    __device__ __forceinline__ void a_ready(const Unit&) const {}
    __device__ __forceinline__ void done(const Unit&) const {}
};

__device__ __forceinline__ unsigned cvt_pk_bf16(float lo, float hi) { unsigned r; asm volatile("v_cvt_pk_bf16_f32 %0, %1, %2" : "=v"(r) : "v"(lo), "v"(hi)); return r; }
typedef float f32x2 __attribute__((ext_vector_type(2)));
__device__ __forceinline__ f32x2 gelu_pk(f32x2 v) {
    const f32x2 av = __builtin_elementwise_abs(v), d = av * 0.2316418882f + 1.0f;
    f32x2 t; t.x = __builtin_amdgcn_rcpf(d.x); t.y = __builtin_amdgcn_rcpf(d.y);
    f32x2 q = t * 0.5307027145f + (-0.7265760135f); q = q * t + 0.7107068705f; q = q * t + (-0.142248368f); q = q * t + 0.127414796f; q = q * t;
    const f32x2 s = (v * v) * (-0.72134752044f);
    f32x2 e; e.x = __builtin_amdgcn_exp2f(s.x); e.y = __builtin_amdgcn_exp2f(s.y);
    const f32x2 m = v * (q * e), r = v - m;
    f32x2 o; o.x = v.x < 0.f ? m.x : r.x; o.y = v.y < 0.f ? m.y : r.y; return o;
}

template <int ACT  > struct EpiBf16 {
    static constexpr bool PERM = true, AFTER_DRAIN = false; static_assert(ACT == 0 || ACT == 1, "EpiBf16: ACT is 0 (none) or 1 (gelu_pk)");
    bf16_t* O; int ldc; const float* bias; int split_cols; size_t split_stride; float scale0;
    __device__ __forceinline__ void operator()(const f32x4 (&acc)[2][2][4][2], const Unit& u, int wr, int wc, int fr, int fq) const {
        const int row0 = u.pm * BM + wr * 64 + fr; int colt = u.pn * BM; bf16_t* base = O;
        float sc = 1.f; if (split_cols) { const int t = colt / split_cols; base += (size_t)t * split_stride; colt -= t * split_cols; if (t == 0) sc = scale0; }
        const int col0 = colt + wc * 32 + 8 * fq, bcol0 = u.pn * BM + wc * 32 + 8 * fq;
        f32x4 bv[2][2];
#pragma unroll
        for (int bj = 0; bj < 2; ++bj)
#pragma unroll
            for (int n = 0; n < 2; ++n) bv[bj][n] = bias ? *(const f32x4*)(bias + bcol0 + bj * HALF + 4 * n) : (f32x4){0.f, 0.f, 0.f, 0.f};
#pragma unroll
        for (int ai = 0; ai < 2; ++ai)
#pragma unroll
            for (int m = 0; m < 4; ++m) { bf16_t* rowp = base + (size_t)(row0 + ai * HALF + m * 16) * ldc + col0;
#pragma unroll
                for (int bj = 0; bj < 2; ++bj) { f32x4 v0 = acc[ai][bj][m][0] + bv[bj][0], v1 = acc[ai][bj][m][1] + bv[bj][1];
                    if (ACT == 1) { f32x2 a = gelu_pk((f32x2){v0[0], v0[1]}), b = gelu_pk((f32x2){v0[2], v0[3]}), c = gelu_pk((f32x2){v1[0], v1[1]}), d = gelu_pk((f32x2){v1[2], v1[3]});
                        v0 = (f32x4){a.x, a.y, b.x, b.y}; v1 = (f32x4){c.x, c.y, d.x, d.y}; }
                    v0 = v0 * sc; v1 = v1 * sc; u32x4 w; w.x = cvt_pk_bf16(v0[0], v0[1]); w.y = cvt_pk_bf16(v0[2], v0[3]); w.z = cvt_pk_bf16(v1[0], v1[1]); w.w = cvt_pk_bf16(v1[2], v1[3]);
                    *(u32x4*)(rowp + bj * HALF) = w; } }
    }
};

struct PanelStats {
    unsigned* xbuf;
    unsigned* cnt;
    unsigned* tmo;
    int ntn; float eps;
    unsigned code;
    __device__ __forceinline__ bool run(const f32x4 (&v)[2][2][4][2], const Unit& u, int wr, int wc, int fr, int fq, PG8_LAS unsigned char* lds, int wid, int lane) const {
        typedef float f32x2v __attribute__((ext_vector_type(2)));
        PG8_LAS f32x2v* P = (PG8_LAS f32x2v*)lds;
        PG8_LAS f32x2v* S = (PG8_LAS f32x2v*)(lds + 8192);
        PG8_LAS unsigned* flag = (PG8_LAS unsigned*)(lds + 8192 + 2048);
#pragma unroll
        for (int ai = 0; ai < 2; ++ai)
#pragma unroll
            for (int m = 0; m < 4; ++m) {
                float s = 0.f;
#pragma unroll
                for (int bj = 0; bj < 2; ++bj)
#pragma unroll
                    for (int n = 0; n < 2; ++n) { const f32x4 x = v[ai][bj][m][n]; s += (x[0] + x[1]) + (x[2] + x[3]); }
                s += __shfl_xor(s, 16); s += __shfl_xor(s, 32);
                const float mw = s * (1.0f / 64.0f); float q = 0.f;
#pragma unroll
                for (int bj = 0; bj < 2; ++bj)
#pragma unroll
                    for (int n = 0; n < 2; ++n) { const f32x4 d = v[ai][bj][m][n] - mw; q += (d[0] * d[0] + d[1] * d[1]) + (d[2] * d[2] + d[3] * d[3]); }
                q += __shfl_xor(q, 16); q += __shfl_xor(q, 32);
                if (fq == 0) P[(ai * HALF + wr * 64 + m * 16 + fr) * 4 + wc] = (f32x2v){mw, q};
            }
        asm volatile("s_waitcnt lgkmcnt(0)" ::: "memory"); __builtin_amdgcn_s_barrier(); asm volatile("" ::: "memory");
#if defined(BROKEN_EXCHANGE_NO_WAIT)
#warning BROKEN CONTROL BUILD: the row-statistics exchange does not wait; results are wrong by design
        if (blockIdx.x >= 64) { const long long t0_ = clock64(); while (clock64() - t0_ < 60000) __builtin_amdgcn_s_sleep(8); }
#endif
        const int row = wid * 32 + (lane & 31);
        if (lane < 32) {
            const f32x2v a = P[row * 4 + 0], b = P[row * 4 + 1], c = P[row * 4 + 2], d = P[row * 4 + 3];
            const float mt = (a.x + b.x + c.x + d.x) * 0.25f;
            const float da = a.x - mt, db = b.x - mt, dc = c.x - mt, dd = d.x - mt;
            const float m2 = (a.y + b.y) + (c.y + d.y) + 64.0f * ((da * da + db * db) + (dc * dc + dd * dd));
            unsigned long long* slot = (unsigned long long*)xbuf + ((size_t)(u.pm * BM + row) * 4 + u.pn);
            __hip_atomic_store(slot, ((unsigned long long)__float_as_uint(m2) << 32) | __float_as_uint(mt), __ATOMIC_RELAXED, __HIP_MEMORY_SCOPE_AGENT);
        }
        asm volatile("s_waitcnt vmcnt(0)" ::: "memory");
        if (lane == 0) __hip_atomic_fetch_add(cnt + 64 * u.pm, 1u, __ATOMIC_RELAXED, __HIP_MEMORY_SCOPE_AGENT);
        if (wid == 0) {
            bool dead = false; const unsigned long long t0 = __builtin_amdgcn_s_memrealtime(); const unsigned want = 8u * (unsigned)ntn;
            for (;;) {
#if defined(BROKEN_EXCHANGE_NO_WAIT)
                break;
#endif
                if ((unsigned)__builtin_amdgcn_readfirstlane(__hip_atomic_load(cnt + 64 * u.pm, __ATOMIC_RELAXED, __HIP_MEMORY_SCOPE_AGENT)) >= want) break;
                if (__builtin_amdgcn_s_memrealtime() - t0 > 2000000ull) {
                    if (lane == 0) { unsigned expect = 0u; __hip_atomic_compare_exchange_strong(tmo + 1, &expect, code | (unsigned)(u.pm & 0xff), __ATOMIC_RELAXED, __ATOMIC_RELAXED, __HIP_MEMORY_SCOPE_AGENT);
                                     __hip_atomic_store(tmo, 1u, __ATOMIC_RELAXED, __HIP_MEMORY_SCOPE_AGENT); }
                    dead = true; break; }
                __builtin_amdgcn_s_sleep(2);
            }
            __builtin_amdgcn_fence(__ATOMIC_ACQUIRE, "agent");
            if (lane == 0) flag[0] = dead ? 1u : 0u;
        }
        asm volatile("s_waitcnt vmcnt(0) lgkmcnt(0)" ::: "memory"); __builtin_amdgcn_s_barrier(); asm volatile("" ::: "memory");
        const bool bad = flag[0] != 0u;
        if (lane < 32) {
            const unsigned long long* slot = (const unsigned long long*)xbuf + (size_t)(u.pm * BM + row) * 4; float mt[4], m2[4]; float ms = 0.f;
#pragma unroll
            for (int t = 0; t < 4; ++t) { if (t < ntn) { const unsigned long long w = __hip_atomic_load(slot + t, __ATOMIC_RELAXED, __HIP_MEMORY_SCOPE_AGENT); mt[t] = __uint_as_float((unsigned)w); m2[t] = __uint_as_float((unsigned)(w >> 32)); } else { mt[t] = 0.f; m2[t] = 0.f; } ms += mt[t]; }
            const float mean = ms / (float)ntn; float q = 0.f;
#pragma unroll
            for (int t = 0; t < 4; ++t) if (t < ntn) { const float dm = mt[t] - mean; q += m2[t] + 256.0f * dm * dm; }
            S[row] = (f32x2v){mean, 1.0f / sqrtf(q / (256.0f * (float)ntn) + eps)};
        }
        asm volatile("s_waitcnt lgkmcnt(0)" ::: "memory"); __builtin_amdgcn_s_barrier(); asm volatile("" ::: "memory");
        return bad;
    }
};
struct EpiLnRes {
    static constexpr bool PERM = false, AFTER_DRAIN = true;
    const float* base; float* out; int ldc; const float* bias; PanelStats st; unsigned poison;
    __device__ __forceinline__ void fused(f32x4 (&acc)[2][2][4][2], const Unit& u, int wr, int wc, int fr, int fq, PG8_LAS unsigned char* lds, int wid, int lane) const {
        typedef float f32x2v __attribute__((ext_vector_type(2)));
        const PG8_LAS f32x2v* S = (const PG8_LAS f32x2v*)(lds + 8192);
        const int col0 = u.pn * BM + wc * 32 + 4 * fq;
#pragma unroll
        for (int bj = 0; bj < 2; ++bj)
#pragma unroll
            for (int n = 0; n < 2; ++n) { const f32x4 bv = bias ? *(const f32x4*)(bias + col0 + bj * HALF + n * 16) : (f32x4){0.f, 0.f, 0.f, 0.f};
#pragma unroll
                for (int ai = 0; ai < 2; ++ai)
#pragma unroll
                    for (int m = 0; m < 4; ++m) acc[ai][bj][m][n] += bv; }
        f32x4 pre[4][2][2];
#pragma unroll
        for (int m = 0; m < 4; ++m) { const size_t off = (size_t)(u.pm * BM + wr * 64 + m * 16 + fr) * ldc + col0;
#pragma unroll
            for (int bj = 0; bj < 2; ++bj)
#pragma unroll
                for (int n = 0; n < 2; ++n) pre[m][bj][n] = *(const f32x4*)(base + off + bj * HALF + n * 16); }
        const bool bad = st.run(acc, u, wr, wc, fr, fq, lds, wid, lane) || poison != 0u;
        const float qnan = __builtin_nanf("");
#pragma unroll
        for (int ai = 0; ai < 2; ++ai)
#pragma unroll
            for (int m = 0; m < 4; ++m) { const int r = ai * HALF + wr * 64 + m * 16 + fr; const f32x2v sr = S[r]; const size_t off = (size_t)(u.pm * BM + r) * ldc + col0;
#pragma unroll
                for (int bj = 0; bj < 2; ++bj)
#pragma unroll
                    for (int n = 0; n < 2; ++n) { const f32x4 bs = ai == 0 ? pre[m][bj][n] : *(const f32x4*)(base + off + bj * HALF + n * 16); f32x4 o = bs + (acc[ai][bj][m][n] - sr.x) * sr.y;
                        if (bad) o = (f32x4){qnan, qnan, qnan, qnan}; *(f32x4*)(out + off + bj * HALF + n * 16) = o; }
                if (m & 1) asm volatile("" ::: "memory"); }
    }
};
struct EpiLnResLn {
    static constexpr bool PERM = false, AFTER_DRAIN = true;
    const float* base; float* out; bf16_t* xn; int ldc; const float* bias; PanelStats st1, st2; unsigned poison;
    __device__ __forceinline__ void fused(f32x4 (&acc)[2][2][4][2], const Unit& u, int wr, int wc, int fr, int fq, PG8_LAS unsigned char* lds, int wid, int lane) const {
        typedef float f32x2v __attribute__((ext_vector_type(2))); typedef unsigned u32x2v __attribute__((ext_vector_type(2)));
        const PG8_LAS f32x2v* S = (const PG8_LAS f32x2v*)(lds + 8192);
        const int col0 = u.pn * BM + wc * 32 + 4 * fq;
#pragma unroll
        for (int bj = 0; bj < 2; ++bj)
#pragma unroll
            for (int n = 0; n < 2; ++n) { const f32x4 bv = bias ? *(const f32x4*)(bias + col0 + bj * HALF + n * 16) : (f32x4){0.f, 0.f, 0.f, 0.f};
#pragma unroll
                for (int ai = 0; ai < 2; ++ai)
#pragma unroll
                    for (int m = 0; m < 4; ++m) acc[ai][bj][m][n] += bv; }
        bool bad = st1.run(acc, u, wr, wc, fr, fq, lds, wid, lane) || poison != 0u;
        const float qnan = __builtin_nanf("");
#pragma unroll
        for (int ai = 0; ai < 2; ++ai)
#pragma unroll
            for (int m = 0; m < 4; ++m) { const int r = ai * HALF + wr * 64 + m * 16 + fr; const f32x2v sr = S[r]; const size_t off = (size_t)(u.pm * BM + r) * ldc + col0;
#pragma unroll
                for (int bj = 0; bj < 2; ++bj)
#pragma unroll
                    for (int n = 0; n < 2; ++n) { const f32x4 bs = *(const f32x4*)(base + off + bj * HALF + n * 16); acc[ai][bj][m][n] = bs + (acc[ai][bj][m][n] - sr.x) * sr.y; }
                asm volatile("" : "+v"(acc[ai][0][m][0]), "+v"(acc[ai][0][m][1]), "+v"(acc[ai][1][m][0]), "+v"(acc[ai][1][m][1]));
                if (m & 1) asm volatile("" ::: "memory"); }
        const bool bad1 = bad;
        bad = st2.run(acc, u, wr, wc, fr, fq, lds, wid, lane) || bad;
#pragma unroll
        for (int ai = 0; ai < 2; ++ai)
#pragma unroll
            for (int m = 0; m < 4; ++m) { const int r = ai * HALF + wr * 64 + m * 16 + fr; const f32x2v sr = S[r]; const size_t off = (size_t)(u.pm * BM + r) * ldc + col0;
#pragma unroll
                for (int bj = 0; bj < 2; ++bj)
#pragma unroll
                    for (int n = 0; n < 2; ++n) { const f32x4 x1 = acc[ai][bj][m][n]; *(f32x4*)(out + off + bj * HALF + n * 16) = bad1 ? (f32x4){qnan, qnan, qnan, qnan} : x1;
                        const f32x4 o = (x1 - sr.x) * sr.y; u32x2v w; w.x = cvt_pk_bf16(o[0], o[1]); w.y = cvt_pk_bf16(o[2], o[3]);
                        if (bad) { w.x = 0x7fc07fc0u; w.y = 0x7fc07fc0u; } *(u32x2v*)(xn + off + bj * HALF + n * 16) = w; }
                asm volatile("" ::: "memory"); }
    }
};

template <class Epi, class Sched, bool ALIGN_EPI = false, bool SP2 = false>
__device__ __forceinline__ void gemm_phase(PG8_LAS unsigned char* lds, const Gemm g, const Sched& S, const Epi& E, const int wave_s) {
    int tid_ = wave_s * 64 + (int)__builtin_amdgcn_mbcnt_hi(~0u, __builtin_amdgcn_mbcnt_lo(~0u, 0u)); asm volatile("" : "+v"(tid_));
    const int tid = tid_, wid = __builtin_amdgcn_readfirstlane(tid >> 6), lane = tid & 63, wr = wid >> 2, wc = wid & 3, fr = lane & 15, fq = lane >> 4;
    const int K = g.K, nt = K / BK;
    unsigned voffA[2], voffB[2];
#pragma unroll
    for (int i = 0; i < 2; ++i) { int R, C; stage_rc(tid * 16 + i * 8192, R, C); const int Rb = Epi::PERM ? ((R & ~31) + perm32(R & 31)) : R;
        voffA[i] = (unsigned)(R * (g.blkA ? BK : K) + C) * 2u; voffB[i] = (unsigned)(Rb * (g.blkB ? BK : K) + C) * 2u; }
    const size_t kstepA = g.blkA ? (size_t)BM * BK * 2 : (size_t)(BK * 2), kstepB = g.blkB ? (size_t)BM * BK * 2 : (size_t)(BK * 2);
    const size_t hstepA = g.blkA ? (size_t)HALF * BK * 2 : (size_t)HALF * K * 2, hstepB = g.blkB ? (size_t)HALF * BK * 2 : (size_t)HALF * K * 2;
    const size_t tstepA = (size_t)BM * K * 2, tstepB = tstepA;
    const unsigned ldsw = (unsigned)wid * 1024u;
    const int aoff = lds_byte(wr * 64 + fr, fq * 8), boff = lds_byte(wc * 32 + fr, fq * 8);
#define PG8_SA(b, h) (((b) * 2 + (h)) * HTB)
#define PG8_SB(b, h) ((4 + (b) * 2 + (h)) * HTB)
#define PG8_STAGE(bufoff, gbase, voff) do { _Pragma("unroll") for (int _i = 0; _i < 2; ++_i) \
        __builtin_amdgcn_global_load_lds((const unsigned*)((const char*)(gbase) + (voff)[_i]), (PG8_LAS unsigned*)(lds + (bufoff) + ldsw + _i * 8192), 16, 0, 0); } while (0)
#define PG8_LDA(dst, b, h) do { _Pragma("unroll") for (int m = 0; m < 4; ++m) _Pragma("unroll") for (int k = 0; k < 2; ++k) dst[m][k] = *(const PG8_LAS bf16x8*)(lds + PG8_SA(b, h) + aoff + m * 2048 + k * 1024); } while (0)
#define PG8_LDB(dst, b, h) do { _Pragma("unroll") for (int n = 0; n < 2; ++n) _Pragma("unroll") for (int k = 0; k < 2; ++k) dst[n][k] = *(const PG8_LAS bf16x8*)(lds + PG8_SB(b, h) + boff + n * 2048 + k * 1024); } while (0)
#define PG8_MMA(ai, bj, At, Bt) do { __builtin_amdgcn_s_setprio(1); _Pragma("unroll") for (int m = 0; m < 4; ++m) _Pragma("unroll") for (int n = 0; n < 2; ++n) _Pragma("unroll") for (int k = 0; k < 2; ++k) \
        acc[ai][bj][m][n] = __builtin_amdgcn_mfma_f32_16x16x32_bf16(Bt[n][k], At[m][k], acc[ai][bj][m][n], 0, 0, 0); __builtin_amdgcn_s_setprio(0); } while (0)
#define PG8_WAIT_V(n) asm volatile("s_waitcnt vmcnt(" #n ")" ::: "memory")
#define PG8_WAIT_L(n) asm volatile("s_waitcnt lgkmcnt(" #n ")" ::: "memory")
#define PG8_BAR __builtin_amdgcn_s_barrier()
#define PG8_SCHED __builtin_amdgcn_sched_barrier(0)
    Unit cur, nxt; int ui = 0;
    if (!S.next(0, cur)) return;
    f32x4 acc[2][2][4][2];
#pragma unroll
    for (int a = 0; a < 2; ++a)
#pragma unroll
        for (int b = 0; b < 2; ++b)
#pragma unroll
            for (int m = 0; m < 4; ++m)
#pragma unroll
                for (int n = 0; n < 2; ++n) acc[a][b][m][n] = (f32x4){0.f, 0.f, 0.f, 0.f};
    bf16x8 At[4][2], B0[2][2], B1[2][2];
    const char* cA = (const char*)g.A + (size_t)cur.pm * tstepA; const char* cB = (const char*)g.Bt + (size_t)cur.pn * tstepB;
    S.a_ready(cur);
    if constexpr (SP2) {
        PG8_STAGE(PG8_SB(0, 0), cB, voffB); PG8_STAGE(PG8_SB(0, 1), cB + hstepB, voffB); PG8_STAGE(PG8_SA(0, 0), cA, voffA); PG8_STAGE(PG8_SA(0, 1), cA + hstepA, voffA);
        if (wr == 1) PG8_BAR;
        PG8_WAIT_V(2); PG8_BAR;
        PG8_STAGE(PG8_SB(1, 0), cB + kstepB, voffB); PG8_STAGE(PG8_SA(1, 0), cA + kstepA, voffA); PG8_STAGE(PG8_SB(1, 1), cB + hstepB + kstepB, voffB);
        PG8_WAIT_V(6); PG8_BAR;
    } else {
        PG8_STAGE(PG8_SB(0, 0), cB, voffB); PG8_STAGE(PG8_SA(0, 0), cA, voffA); PG8_STAGE(PG8_SB(0, 1), cB + hstepB, voffB); PG8_STAGE(PG8_SA(0, 1), cA + hstepA, voffA);
        if (wr == 1) PG8_BAR;
        PG8_WAIT_V(4); PG8_BAR;
        PG8_STAGE(PG8_SB(1, 0), cB + kstepB, voffB); PG8_STAGE(PG8_SA(1, 0), cA + kstepA, voffA); PG8_STAGE(PG8_SB(1, 1), cB + hstepB + kstepB, voffB);
        PG8_WAIT_V(6); PG8_BAR;
    }
    for (;;) {
        const bool has_next = S.next(ui + 1, nxt);
        const char* nA = has_next ? (const char*)g.A + (size_t)nxt.pm * tstepA : cA; const char* nB = has_next ? (const char*)g.Bt + (size_t)nxt.pn * tstepB : cB;
#pragma unroll 1
        for (int t = 0; t < nt; t += 2) {
            const bool last = (t == nt - 2);
            const char* a1 = cA + (size_t)(t + 1) * kstepA;
            const char* a2 = last ? nA : cA + (size_t)(t + 2) * kstepA; const char* b2 = last ? nB : cB + (size_t)(t + 2) * kstepB;
            const char* a3 = a2 + kstepA; const char* b3 = b2 + kstepB;
            if (last && has_next) S.a_ready(nxt);
            if constexpr (SP2) {
            PG8_LDB(B0, 0, 0); PG8_LDB(B1, 0, 1); PG8_SCHED; PG8_LDA(At, 0, 0); PG8_STAGE(PG8_SA(1, 1), a1 + hstepA, voffA);
            PG8_WAIT_V(8); PG8_WAIT_L(0); PG8_BAR; PG8_MMA(0, 0, At, B0); PG8_MMA(0, 1, At, B1); PG8_BAR; PG8_SCHED;
            PG8_LDA(At, 0, 1); PG8_STAGE(PG8_SB(0, 0), b2, voffB); PG8_STAGE(PG8_SB(0, 1), b2 + hstepB, voffB); PG8_STAGE(PG8_SA(0, 0), a2, voffA);
            PG8_WAIT_V(8); PG8_WAIT_L(0); PG8_BAR; PG8_MMA(1, 0, At, B0); PG8_MMA(1, 1, At, B1); PG8_BAR; PG8_SCHED;
            PG8_LDB(B0, 1, 0); PG8_LDB(B1, 1, 1); PG8_SCHED; PG8_LDA(At, 1, 0); PG8_STAGE(PG8_SA(0, 1), a2 + hstepA, voffA);
            PG8_WAIT_V(8); PG8_WAIT_L(0); PG8_BAR; PG8_MMA(0, 0, At, B0); PG8_MMA(0, 1, At, B1); PG8_BAR; PG8_SCHED;
            PG8_LDA(At, 1, 1); PG8_STAGE(PG8_SB(1, 0), b3, voffB); PG8_STAGE(PG8_SB(1, 1), b3 + hstepB, voffB); PG8_STAGE(PG8_SA(1, 0), a3, voffA);
            PG8_WAIT_V(8); PG8_WAIT_L(0); PG8_BAR; PG8_MMA(1, 0, At, B0); PG8_MMA(1, 1, At, B1); PG8_BAR; PG8_SCHED;
            } else {
            PG8_LDB(B0, 0, 0); PG8_SCHED; PG8_LDA(At, 0, 0); PG8_STAGE(PG8_SA(1, 1), a1 + hstepA, voffA);
            PG8_WAIT_L(8); PG8_BAR; PG8_WAIT_L(0); PG8_MMA(0, 0, At, B0); PG8_BAR; PG8_SCHED;
            PG8_LDB(B1, 0, 1); PG8_STAGE(PG8_SB(0, 0), b2, voffB);
            PG8_BAR; PG8_WAIT_L(0); PG8_MMA(0, 1, At, B1); PG8_BAR;
            PG8_LDA(At, 0, 1); PG8_STAGE(PG8_SA(0, 0), a2, voffA);
            PG8_BAR; PG8_WAIT_L(0); PG8_MMA(1, 0, At, B0); PG8_BAR; PG8_SCHED;
            PG8_STAGE(PG8_SB(0, 1), b2 + hstepB, voffB);
            PG8_WAIT_V(6); PG8_BAR; PG8_MMA(1, 1, At, B1); PG8_BAR;
            PG8_LDB(B0, 1, 0); PG8_SCHED; PG8_LDA(At, 1, 0); PG8_STAGE(PG8_SA(0, 1), a2 + hstepA, voffA);
            PG8_WAIT_L(8); PG8_BAR; PG8_WAIT_L(0); PG8_MMA(0, 0, At, B0); PG8_BAR; PG8_SCHED;
            PG8_LDB(B1, 1, 1); PG8_STAGE(PG8_SB(1, 0), b3, voffB);
            PG8_BAR; PG8_WAIT_L(0); PG8_MMA(0, 1, At, B1); PG8_BAR;
            PG8_LDA(At, 1, 1); PG8_STAGE(PG8_SA(1, 0), a3, voffA);
            PG8_BAR; PG8_WAIT_L(0); PG8_MMA(1, 0, At, B0); PG8_BAR; PG8_SCHED;
            PG8_STAGE(PG8_SB(1, 1), b3 + hstepB, voffB);
            PG8_WAIT_V(6); PG8_BAR; PG8_MMA(1, 1, At, B1); PG8_BAR;
            }
        }
        if constexpr (ALIGN_EPI) { if (wr == 0) PG8_BAR; }
        if constexpr (!Epi::AFTER_DRAIN) { E(acc, cur, wr, wc, fr, fq); S.done(cur); }
        if (!has_next) break;
#pragma unroll
        for (int a = 0; a < 2; ++a)
#pragma unroll
            for (int b = 0; b < 2; ++b)
#pragma unroll
                for (int m = 0; m < 4; ++m)
#pragma unroll
                    for (int n = 0; n < 2; ++n) acc[a][b][m][n] = (f32x4){0.f, 0.f, 0.f, 0.f};
        cur = nxt; cA = nA; cB = nB; ++ui;
        if constexpr (ALIGN_EPI) { if (wr == 1) PG8_BAR; }
    }
    PG8_WAIT_V(0);
    if constexpr (!ALIGN_EPI) { if (wr == 0) PG8_BAR; }
    PG8_BAR;
    if constexpr (Epi::AFTER_DRAIN) { E.fused(acc, cur, wr, wc, fr, fq, lds, wid, lane); S.done(cur); }
#undef PG8_SA
#undef PG8_SB
#undef PG8_STAGE
#undef PG8_LDA
#undef PG8_LDB
#undef PG8_MMA
#undef PG8_WAIT_V
#undef PG8_WAIT_L
#undef PG8_BAR
#undef PG8_SCHED
}
}
namespace pg8 {
constexpr float LOG2E = 1.4426950408889634f;
__device__ __forceinline__ float sigmoid_f(float z) { return __builtin_amdgcn_rcpf(1.0f + __builtin_amdgcn_exp2f(-LOG2E * z)); }
__device__ __forceinline__ float silu_f(float g) { return g * sigmoid_f(g); }
__device__ __forceinline__ float gelu_tanh_f(float x) { const float z = 1.5957691216057308f * (x + 0.044715f * x * x * x); return x * sigmoid_f(z); }
__device__ __forceinline__ float bf16_lo(unsigned w) { return __uint_as_float(w << 16); }
__device__ __forceinline__ float bf16_hi(unsigned w) { return __uint_as_float(w & 0xffff0000u); }

struct EpiSwiGLU {
    static constexpr bool PERM = true, AFTER_DRAIN = false;
    bf16_t* O; int ldc; int blk;
    __device__ __forceinline__ void operator()(const f32x4 (&acc)[2][2][4][2], const Unit& u, int wr, int wc, int fr, int fq) const {
        const int row0 = u.pm * BM + wr * 64 + fr, col0 = u.pn * HALF + wc * 32 + 8 * fq;
#pragma unroll
        for (int ai = 0; ai < 2; ++ai)
#pragma unroll
            for (int m = 0; m < 4; ++m) {
                const int row = row0 + ai * HALF + m * 16;
                bf16_t* p = blk ? O + ((size_t)(row >> 8) * (ldc >> 6) + (col0 >> 6)) * 16384 + (row & 255) * 64 + (col0 & 63) : O + (size_t)row * ldc + col0;
                const f32x4 g0 = acc[ai][0][m][0], g1 = acc[ai][0][m][1], u0 = acc[ai][1][m][0], u1 = acc[ai][1][m][1];
                u32x4 w;
                w.x = cvt_pk_bf16(silu_f(g0[0]) * u0[0], silu_f(g0[1]) * u0[1]); w.y = cvt_pk_bf16(silu_f(g0[2]) * u0[2], silu_f(g0[3]) * u0[3]);
                w.z = cvt_pk_bf16(silu_f(g1[0]) * u1[0], silu_f(g1[1]) * u1[1]); w.w = cvt_pk_bf16(silu_f(g1[2]) * u1[2], silu_f(g1[3]) * u1[3]);
                *(u32x4*)p = w;
#ifndef SWIGLU_NOSB
                __builtin_amdgcn_sched_barrier(0);
#endif
            }
    }
};
struct EpiBf16SS {
    static constexpr bool PERM = true, AFTER_DRAIN = false;
    bf16_t* O; int ldc; float* ss; int ss_ld;
    __device__ __forceinline__ void operator()(const f32x4 (&acc)[2][2][4][2], const Unit& u, int wr, int wc, int fr, int fq) const {
        const int row0 = u.pm * BM + wr * 64 + fr, col0 = u.pn * BM + wc * 32 + 8 * fq;
#pragma unroll
        for (int ai = 0; ai < 2; ++ai)
#pragma unroll
            for (int m = 0; m < 4; ++m) {
                const int row = row0 + ai * HALF + m * 16; bf16_t* p = O + (size_t)row * ldc + col0; float q = 0.f;
#pragma unroll
                for (int bj = 0; bj < 2; ++bj) { const f32x4 v0 = acc[ai][bj][m][0], v1 = acc[ai][bj][m][1];
                    q += (v0[0] * v0[0] + v0[1] * v0[1]) + (v0[2] * v0[2] + v0[3] * v0[3]) + (v1[0] * v1[0] + v1[1] * v1[1]) + (v1[2] * v1[2] + v1[3] * v1[3]);
                    u32x4 w; w.x = cvt_pk_bf16(v0[0], v0[1]); w.y = cvt_pk_bf16(v0[2], v0[3]); w.z = cvt_pk_bf16(v1[0], v1[1]); w.w = cvt_pk_bf16(v1[2], v1[3]);
                    *(u32x4*)(p + bj * HALF) = w; }
                q += __shfl_xor(q, 16); q += __shfl_xor(q, 32);
                if (fq == 0) ss[(size_t)row * ss_ld + u.pn * 4 + wc] = q;
            }
    }
};
struct EpiWin {
    static constexpr bool PERM = true, AFTER_DRAIN = false;
    bf16_t* Q; bf16_t* Kb; bf16_t* Vb; bf16_t* As;
    __device__ __forceinline__ void operator()(const f32x4 (&acc)[2][2][4][2], const Unit& u, int wr, int wc, int fr, int fq) const {
        const int row0 = u.pm * BM + wr * 64 + fr, cl = wc * 32 + 8 * fq;
#pragma unroll
        for (int ai = 0; ai < 2; ++ai)
#pragma unroll
            for (int m = 0; m < 4; ++m) {
                const int row = row0 + ai * HALF + m * 16;
#pragma unroll
                for (int bj = 0; bj < 2; ++bj) { const float qs = (u.pn < 2) ? 0.125f * LOG2E : 1.0f;
                    const f32x4 v0 = acc[ai][bj][m][0] * qs, v1 = acc[ai][bj][m][1] * qs;
                    u32x4 w; w.x = cvt_pk_bf16(v0[0], v0[1]); w.y = cvt_pk_bf16(v0[2], v0[3]); w.z = cvt_pk_bf16(v1[0], v1[1]); w.w = cvt_pk_bf16(v1[2], v1[3]);
                    bf16_t* p;
                    if (u.pn < 2) p = Q + (size_t)row * 512 + u.pn * 256 + bj * HALF + cl;
                    else if (u.pn == 2) p = (bj == 0 ? Kb : Vb) + (size_t)row * 128 + cl;
                    else { const int ch = (u.pn - 3) * 256 + bj * HALF + cl, g = ch >> 4, h0 = ch & 15;
                        p = As + ((size_t)(g * 2048 + (row >> 4)) * 384 + (row & 15) * 16 + h0); }
                    *(u32x4*)p = w; }
            }
    }
};
struct EpiSsmY {
    static constexpr bool PERM = true, AFTER_DRAIN = false;
    bf16_t* YG;
    __device__ __forceinline__ void operator()(const f32x4 (&acc)[2][2][4][2], const Unit& u, int wr, int wc, int fr, int fq) const {
        const int g = u.pn, n0 = (u.pm & 7) * BM + wr * 64 + fr;
#pragma unroll
        for (int ai = 0; ai < 2; ++ai)
#pragma unroll
            for (int m = 0; m < 4; ++m) {
                const int n = n0 + ai * HALF + m * 16;
#pragma unroll
                for (int bj = 0; bj < 2; ++bj) { const f32x4 v0 = acc[ai][bj][m][0], v1 = acc[ai][bj][m][1];
                    const int i = bj * 8 + wc * 2 + (fq >> 1), h0 = (fq & 1) * 8;
                    u32x4 w; w.x = cvt_pk_bf16(gelu_tanh_f(v0[0]), gelu_tanh_f(v0[1])); w.y = cvt_pk_bf16(gelu_tanh_f(v0[2]), gelu_tanh_f(v0[3]));
                    w.z = cvt_pk_bf16(gelu_tanh_f(v1[0]), gelu_tanh_f(v1[1])); w.w = cvt_pk_bf16(gelu_tanh_f(v1[2]), gelu_tanh_f(v1[3]));
                    *(u32x4*)(YG + (size_t)(n * 16 + i) * 512 + g * 16 + h0) = w; __builtin_amdgcn_sched_barrier(0); }
            }
    }
};
struct EpiGlu {
    static constexpr bool PERM = true, AFTER_DRAIN = false;
    const bf16_t* YG; bf16_t* O; const float* bias; float* ss;
    __device__ __forceinline__ void operator()(const f32x4 (&acc)[2][2][4][2], const Unit& u, int wr, int wc, int fr, int fq) const {
        const int row0 = u.pm * BM + wr * 64 + fr, col0 = u.pn * BM + wc * 32 + 8 * fq;
        f32x4 bv[2][2];
#pragma unroll
        for (int bj = 0; bj < 2; ++bj)
#pragma unroll
            for (int n = 0; n < 2; ++n) bv[bj][n] = *(const f32x4*)(bias + col0 + bj * HALF + 4 * n);
#pragma unroll
        for (int ai = 0; ai < 2; ++ai)
#pragma unroll
            for (int m = 0; m < 4; ++m) {
                const int row = row0 + ai * HALF + m * 16; float q = 0.f;
#pragma unroll
                for (int bj = 0; bj < 2; ++bj) { const f32x4 z0 = acc[ai][bj][m][0] + bv[bj][0], z1 = acc[ai][bj][m][1] + bv[bj][1];
                    const u32x4 yw = *(const u32x4*)(YG + (size_t)row * 512 + col0 + bj * HALF);
                    const float o0 = bf16_lo(yw.x) * sigmoid_f(z0[0]), o1 = bf16_hi(yw.x) * sigmoid_f(z0[1]), o2 = bf16_lo(yw.y) * sigmoid_f(z0[2]), o3 = bf16_hi(yw.y) * sigmoid_f(z0[3]);
                    const float o4 = bf16_lo(yw.z) * sigmoid_f(z1[0]), o5 = bf16_hi(yw.z) * sigmoid_f(z1[1]), o6 = bf16_lo(yw.w) * sigmoid_f(z1[2]), o7 = bf16_hi(yw.w) * sigmoid_f(z1[3]);
                    q += (o0 * o0 + o1 * o1) + (o2 * o2 + o3 * o3) + (o4 * o4 + o5 * o5) + (o6 * o6 + o7 * o7);
                    u32x4 w; w.x = cvt_pk_bf16(o0, o1); w.y = cvt_pk_bf16(o2, o3); w.z = cvt_pk_bf16(o4, o5); w.w = cvt_pk_bf16(o6, o7);
                    *(u32x4*)(O + (size_t)row * 512 + col0 + bj * HALF) = w; __builtin_amdgcn_sched_barrier(0); }
                q += __shfl_xor(q, 16); q += __shfl_xor(q, 32);
                if (fq == 0) ss[(size_t)row * 8 + u.pn * 4 + wc] = q;
            }
    }
};
struct OneUnit {
    int pm, pn;
    __device__ __forceinline__ bool next(int i, Unit& u) const { if (i) return false; u.pm = pm; u.pn = pn; return true; }
    __device__ __forceinline__ void a_ready(const Unit&) const {}
    __device__ __forceinline__ void done(const Unit&) const {}
};
struct SsmOrder {
    int G, c;
    __device__ __forceinline__ bool next(int i, Unit& u) const { const int L = i * G + c; if (L >= 256) return false; u.pm = L; u.pn = L >> 3; return true; }
    __device__ __forceinline__ void a_ready(const Unit&) const {}
    __device__ __forceinline__ void done(const Unit&) const {}
};
}
namespace pg8 {
struct RowStats {
    unsigned long long* slot;
    unsigned* tmo;
    int ntn; float scale, eps, mul;
    __device__ __forceinline__ void run(const f32x4 (&v)[2][2][4][2], const Unit& u, int wr, int wc, int fr, int fq, PG8_LAS unsigned char* lds, int wid, int lane) const {
        PG8_LAS float* P = (PG8_LAS float*)lds;
        PG8_LAS float* S = (PG8_LAS float*)(lds + 4096);
#pragma unroll
        for (int ai = 0; ai < 2; ++ai)
#pragma unroll
            for (int m = 0; m < 4; ++m) {
                float s = 0.f;
#pragma unroll
                for (int bj = 0; bj < 2; ++bj)
#pragma unroll
                    for (int n = 0; n < 2; ++n) { const f32x4 x = v[ai][bj][m][n]; s += (x[0] * x[0] + x[1] * x[1]) + (x[2] * x[2] + x[3] * x[3]); }
                s += __shfl_xor(s, 16); s += __shfl_xor(s, 32);
                if (fq == 0) P[(ai * HALF + wr * 64 + m * 16 + fr) * 4 + wc] = s;
            }
        asm volatile("s_waitcnt lgkmcnt(0)" ::: "memory"); __builtin_amdgcn_s_barrier(); asm volatile("" ::: "memory");
        if (lane < 32) {
            const int row = wid * 32 + lane;
            const f32x4 p = *(const PG8_LAS f32x4*)(P + row * 4);
            const float tot = (p[0] + p[1]) + (p[2] + p[3]);
            unsigned long long* sp = slot + (size_t)(u.pm * BM + row);
            const unsigned long long mine = (unsigned long long)(tot * 1048576.0f + 0.5f) + (1ull << 48);
            unsigned long long cur = __hip_atomic_fetch_add(sp, mine, __ATOMIC_RELAXED, __HIP_MEMORY_SCOPE_AGENT) + mine;
            unsigned spins = 0;
            while ((unsigned)(cur >> 48) < (unsigned)ntn) {
                __builtin_amdgcn_s_sleep(1);
                cur = __hip_atomic_load(sp, __ATOMIC_RELAXED, __HIP_MEMORY_SCOPE_AGENT);
                if (++spins > (1u << 20)) { __hip_atomic_store(tmo, 1u, __ATOMIC_RELAXED, __HIP_MEMORY_SCOPE_AGENT); break; }
            }
            const float total = (float)(cur & 0xFFFFFFFFFFFFull) * (1.0f / 1048576.0f);
            S[row] = mul / sqrtf(total * scale + eps);
        }
        asm volatile("s_waitcnt lgkmcnt(0)" ::: "memory"); __builtin_amdgcn_s_barrier(); asm volatile("" ::: "memory");
    }
};
template <bool NORM> struct EpiResNorm {
    static constexpr bool PERM = true, AFTER_DRAIN = false;
    const float* xin; float* xout; bf16_t* H; const float* ga; const float* gpost; const float* gpre; const float* sh; const float* sc; int bstride;
    RowStats st1, st2; PG8_LAS unsigned char* xl; int dbg; const float* dup; float* dupw;
    __device__ __forceinline__ void operator()(const f32x4 (&acc_)[2][2][4][2], const Unit& u, int wr, int wc, int fr, int fq) const {
        f32x4 (&acc)[2][2][4][2] = const_cast<f32x4 (&)[2][2][4][2]>(acc_);
        const int wid = wr * 4 + wc, lane = fq * 16 + fr, b = u.pm >> 3;
#ifdef EPI_STAMPS
#define EPI_STAMP(k) do { if (dbg && blockIdx.x == 0 && wid == 0 && lane == 0) { volatile PG8_LAS unsigned* q_ = (volatile PG8_LAS unsigned*)(xl + 12288 + 64 + (40 + (k)) * 4); if (*q_ == 0u) *q_ = (unsigned)__builtin_amdgcn_s_memrealtime(); } } while (0)
#else
#define EPI_STAMP(k) do {} while (0)
#endif
        EPI_STAMP(0);
        const PG8_LAS float* S = (const PG8_LAS float*)(xl + 4096);
        const int col0 = u.pn * BM + wc * 32 + 8 * fq;
        const size_t rbase = (size_t)(u.pm * BM + wr * 64 + fr) * 1024 + col0;
#if defined(EPI_DUP_LD)
#define EPI_DUPLD(m) do { if (dbg) { const f32x4 d0_ = *(const f32x4*)(pin_ + (dup - xin)); bs[2 * (m)] += d0_ * 0.0f; } } while (0)
#else
#define EPI_DUPLD(m) do {} while (0)
#endif
#if defined(EPI_DUP_ST)
#define EPI_DUPST(m) do { if (dbg) { *(f32x4*)(pout_ + (dupw - xout)) = acc[ai_][bj_][m][0]; *(f32x4*)(pout_ + (dupw - xout) + 4) = acc[ai_][bj_][m][1]; } } while (0)
#else
#define EPI_DUPST(m) do {} while (0)
#endif
#define RN_LOAD(k) do { const float* pin_ = xin + rbase + (size_t)(((k) & 1) * HALF) * 1024 + ((k) >> 1) * HALF; _Pragma("unroll") for (int m = 0; m < 4; ++m) { \
            bs[2 * m] = *(const f32x4*)pin_; bs[2 * m + 1] = *(const f32x4*)(pin_ + 4); EPI_DUPLD(m); pin_ += 16 * 1024; asm volatile("" : "+v"(pin_)); } } while (0)
#define RN_COMP(k) do { const int ai_ = (k) & 1, bj_ = (k) >> 1, c_ = col0 + bj_ * HALF; \
            const f32x4 cv0_ = *(const f32x4*)(ga + (size_t)b * bstride + c_) * *(const f32x4*)(gpost + c_), cv1_ = *(const f32x4*)(ga + (size_t)b * bstride + c_ + 4) * *(const f32x4*)(gpost + c_ + 4); \
            _Pragma("unroll") for (int m = 0; m < 4; ++m) { const float sr_ = sr[ai_][m]; \
                acc[ai_][bj_][m][0] = bs[2 * m] + cv0_ * acc[ai_][bj_][m][0] * sr_; acc[ai_][bj_][m][1] = bs[2 * m + 1] + cv1_ * acc[ai_][bj_][m][1] * sr_; } \
            asm volatile("" : "+v"(acc[ai_][bj_][0][0]), "+v"(acc[ai_][bj_][0][1]), "+v"(acc[ai_][bj_][1][0]), "+v"(acc[ai_][bj_][1][1]), "+v"(acc[ai_][bj_][2][0]), "+v"(acc[ai_][bj_][2][1]), "+v"(acc[ai_][bj_][3][0]), "+v"(acc[ai_][bj_][3][1])); \
            __builtin_amdgcn_sched_barrier(0); } while (0)
#define RN_STORE(k) do { const int ai_ = (k) & 1, bj_ = (k) >> 1; float* pout_ = xout + rbase + (size_t)(ai_ * HALF) * 1024 + bj_ * HALF; \
            _Pragma("unroll") for (int m = 0; m < 4; ++m) { *(f32x4*)pout_ = acc[ai_][bj_][m][0]; *(f32x4*)(pout_ + 4) = acc[ai_][bj_][m][1]; EPI_DUPST(m); pout_ += 16 * 1024; asm volatile("" : "+v"(pout_)); } \
            asm volatile("" ::: "memory"); __builtin_amdgcn_sched_barrier(0); } while (0)
        {
            f32x4 bs[8];
            RN_LOAD(0);
            st1.run(acc, u, wr, wc, fr, fq, xl, wid, lane);
            float sr[2][4];
#pragma unroll
            for (int ai = 0; ai < 2; ++ai)
#pragma unroll
                for (int m = 0; m < 4; ++m) sr[ai][m] = S[ai * HALF + wr * 64 + m * 16 + fr];
            EPI_STAMP(1);
            RN_COMP(0); RN_LOAD(1); asm volatile("" ::: "memory"); __builtin_amdgcn_sched_barrier(0); RN_STORE(0);
            RN_COMP(1); RN_LOAD(2); asm volatile("" ::: "memory"); __builtin_amdgcn_sched_barrier(0); RN_STORE(1);
            RN_COMP(2); RN_LOAD(3); asm volatile("" ::: "memory"); __builtin_amdgcn_sched_barrier(0); RN_STORE(2);
            RN_COMP(3); RN_STORE(3);
            EPI_STAMP(2);
        }
#undef RN_LOAD
#undef RN_COMP
#undef RN_STORE
        if (NORM) {
            st2.run(acc, u, wr, wc, fr, fq, xl, wid, lane);
            EPI_STAMP(3);
            float sr[2][4];
#pragma unroll
            for (int ai = 0; ai < 2; ++ai)
#pragma unroll
                for (int m = 0; m < 4; ++m) sr[ai][m] = S[ai * HALF + wr * 64 + m * 16 + fr];
#pragma unroll
            for (int bj = 0; bj < 2; ++bj) { const int c = col0 + bj * HALF; const size_t bo = (size_t)b * bstride + c;
                const f32x4 gv0 = *(const f32x4*)(gpre + c) * (1.0f + *(const f32x4*)(sc + bo)), gv1 = *(const f32x4*)(gpre + c + 4) * (1.0f + *(const f32x4*)(sc + bo + 4));
                const f32x4 hv0 = *(const f32x4*)(sh + bo), hv1 = *(const f32x4*)(sh + bo + 4);
                bf16_t* ph = H + rbase + bj * HALF;
#pragma unroll
                for (int ai = 0; ai < 2; ++ai)
#pragma unroll
                    for (int m = 0; m < 4; ++m) { const f32x4 o0 = acc[ai][bj][m][0] * sr[ai][m] * gv0 + hv0, o1 = acc[ai][bj][m][1] * sr[ai][m] * gv1 + hv1;
                        u32x4 w; w.x = cvt_pk_bf16(o0[0], o0[1]); w.y = cvt_pk_bf16(o0[2], o0[3]); w.z = cvt_pk_bf16(o1[0], o1[1]); w.w = cvt_pk_bf16(o1[2], o1[3]);
                        *(u32x4*)ph = w; ph += (m == 3 ? (HALF - 48) : 16) * 1024; asm volatile("" : "+v"(ph)); }
                asm volatile("" ::: "memory"); __builtin_amdgcn_sched_barrier(0); }
        }
        EPI_STAMP(4);
    }
};
struct EpiGluNorm {
    static constexpr bool PERM = true, AFTER_DRAIN = false;
    const bf16_t* YG; bf16_t* MX; const float* bias; const float* g; RowStats st; PG8_LAS unsigned char* xl;
    __device__ __forceinline__ void operator()(const f32x4 (&acc_)[2][2][4][2], const Unit& u, int wr, int wc, int fr, int fq) const {
        f32x4 (&acc)[2][2][4][2] = const_cast<f32x4 (&)[2][2][4][2]>(acc_);
        const int wid = wr * 4 + wc, lane = fq * 16 + fr;
        const PG8_LAS float* S = (const PG8_LAS float*)(xl + 4096);
        const int row0 = u.pm * BM + wr * 64 + fr, col0 = u.pn * BM + wc * 32 + 8 * fq;
#pragma unroll
        for (int bj = 0; bj < 2; ++bj) {
            const f32x4 bv0 = *(const f32x4*)(bias + col0 + bj * HALF), bv1 = *(const f32x4*)(bias + col0 + bj * HALF + 4);
            u32x4 yw[2][4]; const bf16_t* py = YG + (size_t)row0 * 512 + col0 + bj * HALF;
#pragma unroll
            for (int ai = 0; ai < 2; ++ai)
#pragma unroll
                for (int m = 0; m < 4; ++m) { yw[ai][m] = *(const u32x4*)py; py += (m == 3 ? (HALF - 48) : 16) * 512; asm volatile("" : "+v"(py)); }
#pragma unroll
            for (int ai = 0; ai < 2; ++ai)
#pragma unroll
                for (int m = 0; m < 4; ++m) { const f32x4 z0 = acc[ai][bj][m][0] + bv0, z1 = acc[ai][bj][m][1] + bv1; const u32x4 y = yw[ai][m];
                    acc[ai][bj][m][0] = (f32x4){bf16_lo(y.x) * sigmoid_f(z0[0]), bf16_hi(y.x) * sigmoid_f(z0[1]), bf16_lo(y.y) * sigmoid_f(z0[2]), bf16_hi(y.y) * sigmoid_f(z0[3])};
                    acc[ai][bj][m][1] = (f32x4){bf16_lo(y.z) * sigmoid_f(z1[0]), bf16_hi(y.z) * sigmoid_f(z1[1]), bf16_lo(y.w) * sigmoid_f(z1[2]), bf16_hi(y.w) * sigmoid_f(z1[3])}; }
            asm volatile("" ::: "memory"); __builtin_amdgcn_sched_barrier(0);
        }
        st.run(acc, u, wr, wc, fr, fq, xl, wid, lane);
        float sr[2][4];
#pragma unroll
        for (int ai = 0; ai < 2; ++ai)
#pragma unroll
            for (int m = 0; m < 4; ++m) sr[ai][m] = S[ai * HALF + wr * 64 + m * 16 + fr];
#pragma unroll
        for (int bj = 0; bj < 2; ++bj) {
            const f32x4 gv0 = *(const f32x4*)(g + col0 + bj * HALF), gv1 = *(const f32x4*)(g + col0 + bj * HALF + 4);
            bf16_t* pm_ = MX + (size_t)row0 * 1024 + 512 + col0 + bj * HALF;
#pragma unroll
            for (int ai = 0; ai < 2; ++ai)
#pragma unroll
                for (int m = 0; m < 4; ++m) { const f32x4 o0 = acc[ai][bj][m][0] * sr[ai][m] * gv0, o1 = acc[ai][bj][m][1] * sr[ai][m] * gv1;
                    u32x4 w; w.x = cvt_pk_bf16(o0[0], o0[1]); w.y = cvt_pk_bf16(o0[2], o0[3]); w.z = cvt_pk_bf16(o1[0], o1[1]); w.w = cvt_pk_bf16(o1[2], o1[3]);
                    *(u32x4*)pm_ = w; pm_ += (m == 3 ? (HALF - 48) : 16) * 1024; asm volatile("" : "+v"(pm_)); }
            asm volatile("" ::: "memory"); __builtin_amdgcn_sched_barrier(0);
        }
    }
};
}
#ifndef DOWN_BLK
#define DOWN_BLK 1
#endif
constexpr int NWAVES = 8, NTHR = 512;
constexpr int NB = 16, SEQ = 2048, DM = 1024, M = NB * SEQ, DFF = 2816, DIN = 1280, DATT = 512, DSSM = 512, NGRP = 32, NST = 64, NMOD = 9 * DM;
constexpr int KSS = 384;
constexpr float EPS = 1e-6f;
constexpr size_t MiB = 1u << 20;
constexpr size_t al256(size_t x) { return (x + 255) & ~(size_t)255; }
constexpr size_t WS_CTL = 0, CTL_ZERO_BYTES = 32768;
constexpr size_t WS_XB = MiB;
constexpr size_t WS_W1GU = WS_XB + 6 * (size_t)32768 * 16;
constexpr size_t WS_W1D  = WS_W1GU + al256((size_t)2 * DFF * DM * 2);
constexpr size_t WS_W2GU = WS_W1D + al256((size_t)DM * DFF * 2);
constexpr size_t WS_W2D  = WS_W2GU + al256((size_t)2 * DFF * DM * 2);
constexpr size_t WS_WIN  = WS_W2D + al256((size_t)DM * DFF * 2);
constexpr size_t WS_WGLU = WS_WIN + al256((size_t)DIN * DM * 2);
constexpr size_t WS_WOUT = WS_WGLU + al256((size_t)DSSM * DSSM * 2);
constexpr size_t WS_TW   = WS_WOUT + al256((size_t)DM * DM * 2);
constexpr size_t WS_WS   = WS_TW + al256((size_t)NGRP * 256 * KSS * 2);
constexpr size_t WS_KT   = WS_WS + al256((size_t)NGRP * 128 * 256 * 2);
constexpr size_t WS_A16  = WS_KT + al256((size_t)NGRP * 16 * 256 * 4);
constexpr size_t WS_MOD  = WS_A16 + al256((size_t)2 * NGRP * NST * 4);
constexpr size_t WS_FSS  = WS_MOD + al256((size_t)NB * NMOD * 4);
constexpr size_t WS_SSS  = WS_FSS + al256((size_t)M * 16 * 4);
constexpr size_t WS_H    = al256(WS_SSS + (size_t)M * 8 * 4 + MiB);
constexpr size_t WS_F    = WS_H + (size_t)M * DM * 2;
constexpr size_t WS_SSMR = WS_F + (size_t)M * DM * 2;
constexpr size_t WS_ACT  = WS_SSMR + (size_t)M * DSSM * 2;
constexpr size_t WS_Q    = WS_ACT;
constexpr size_t WS_K    = WS_Q + (size_t)M * DATT * 2;
constexpr size_t WS_V    = WS_K + (size_t)M * 128 * 2;
constexpr size_t WS_AS   = WS_V + (size_t)M * 128 * 2;
constexpr size_t WS_S    = WS_AS + (size_t)NGRP * 2048 * KSS * 2;
constexpr size_t WS_YG   = WS_S + (size_t)NGRP * 2048 * 128 * 4;
constexpr size_t WS_MIXEND = WS_YG + (size_t)M * DSSM * 2;
constexpr size_t WS_END  = WS_ACT + (size_t)M * DFF * 2;
static_assert(WS_MIXEND <= WS_END, "mixer temporaries must fit inside ACT");
constexpr int LDS_BYTES = 147456;
constexpr int LDS_MISC_OFF = 143360;
constexpr int CW_BAR = 1024;
constexpr int CW_TMO = 0, CW_SEAM = 8192, SEAM_BANK = 8192;
constexpr int LDS_X_OFF = 131072;

#define GAS __attribute__((address_space(1)))
#define LAS __attribute__((address_space(3)))
typedef unsigned short bf16;
typedef unsigned v4u __attribute__((ext_vector_type(4)));
typedef unsigned v2u __attribute__((ext_vector_type(2)));
typedef float f32x4 __attribute__((ext_vector_type(4)));
typedef float f32x16 __attribute__((ext_vector_type(16)));
typedef short bf16x8 __attribute__((ext_vector_type(8)));
#define LDS_WAIT() asm volatile("s_waitcnt lgkmcnt(0)" ::: "memory")
__device__ __forceinline__ unsigned f2bf(float f) { unsigned u = __builtin_bit_cast(unsigned, f); return (u + 0x7fffu + ((u >> 16) & 1u)) >> 16; }
__device__ __forceinline__ unsigned pk2(float lo, float hi) { return pg8::cvt_pk_bf16(lo, hi); }
__device__ __forceinline__ float bflo(unsigned w) { return __uint_as_float(w << 16); }
__device__ __forceinline__ float bfhi(unsigned w) { return __uint_as_float(w & 0xffff0000u); }
__device__ __forceinline__ float wave_sum(float v) {
#pragma unroll
    for (int o = 1; o < 64; o <<= 1) v += __shfl_xor(v, o);
    return v;
}

#define XB_TMO      128
#define XB_XCNT(j)  (256  + 64 * (j))
#define XB_XSUB(j)  (1280 + 64 * (j))
#define XB_XGEN(j)  (2304 + 64 * (j))
#define XB_TOP      3328
#define XB_TOPGEN   3392
#define XCD_BAR_WORDS 3456
#define XB_SPIN_CAP (1u << 18)

__device__ __forceinline__ unsigned xb_ld(unsigned* p)              { return __hip_atomic_load(p, __ATOMIC_RELAXED, __HIP_MEMORY_SCOPE_AGENT); }
__device__ __forceinline__ unsigned xb_add(unsigned* p, unsigned v) { return __hip_atomic_fetch_add(p, v, __ATOMIC_RELAXED, __HIP_MEMORY_SCOPE_AGENT); }
__device__ __forceinline__ unsigned xb_xcc_id() { return (unsigned)__builtin_amdgcn_s_getreg((3 << 11) | 20) & 0xFu; }
#define XB_SPIN(cond, bar) do { unsigned _sp = 0; while (cond) { __builtin_amdgcn_s_sleep(1); \
    if ((++_sp & 255u) == 0u) { if (xb_ld(&(bar)[XB_TMO])) break; if (_sp > XB_SPIN_CAP) { atomicAdd(&(bar)[XB_TMO], 1u); break; } } } } while (0)

struct XcdBarrier {
    unsigned* bar; unsigned x;
    volatile LAS unsigned* st;
};

__device__ __forceinline__ XcdBarrier xcd_barrier_post(unsigned* bar, volatile LAS unsigned* st) {
    XcdBarrier b; b.bar = bar; b.x = xb_xcc_id(); b.st = st;
    if (threadIdx.x == 0) (void)xb_add(&bar[XB_XCNT(b.x)], 1u);
    return b;
}
__device__ __forceinline__ void xcd_barrier_complete(unsigned* bar, unsigned x, unsigned& nloc, unsigned& nx) {
    const unsigned G = gridDim.x * gridDim.y * gridDim.z;
    unsigned sum, cnt, mine, sp = 0u;
    for (;;) {
        sum = 0u; cnt = 0u; mine = 0u;
#pragma unroll
        for (unsigned j = 0; j < 16; ++j) { const unsigned c = xb_ld(&bar[XB_XCNT(j)]); sum += c; cnt += (c > 0u) ? 1u : 0u; mine = (j == x) ? c : mine; }
        if (sum == G) break;
        __builtin_amdgcn_s_sleep(1);
        if ((++sp & 255u) == 0u) { if (xb_ld(&bar[XB_TMO])) break; if (sp > XB_SPIN_CAP) { atomicAdd(&bar[XB_TMO], 1u); break; } }
    }
    nloc = mine > 0u ? mine : 1u; nx = cnt > 0u ? cnt : 1u;
}

__device__ __forceinline__ void xcd_barrier(const XcdBarrier& b) {
    asm volatile("s_waitcnt vmcnt(0)" ::: "memory");
    __syncthreads();
    if (threadIdx.x == 0) {
        unsigned* bar = b.bar;
        __builtin_amdgcn_s_waitcnt(0);
        unsigned nloc = b.st[0], nx = b.st[1];
        if (nloc == 0u) { xcd_barrier_complete(bar, b.x, nloc, nx); b.st[0] = nloc; b.st[1] = nx; }
        const unsigned old = xb_add(&bar[XB_XSUB(b.x)], 1u);
        const unsigned gen = old / nloc;
        if (old + 1u == (gen + 1u) * nloc) {
            __builtin_amdgcn_fence(__ATOMIC_RELEASE, "agent");
            asm volatile("s_waitcnt vmcnt(0)" ::: "memory");
            const unsigned og = xb_add(&bar[XB_TOP], 1u);
            const unsigned tg = og / nx;
            if (og + 1u == (tg + 1u) * nx) xb_add(&bar[XB_TOPGEN], 1u);
            else XB_SPIN(xb_ld(&bar[XB_TOPGEN]) == tg, bar);
            __builtin_amdgcn_fence(__ATOMIC_ACQUIRE, "agent");
            xb_add(&bar[XB_XGEN(b.x)], 1u);
            asm volatile("s_waitcnt vmcnt(0)" ::: "memory");
        } else {
            XB_SPIN(xb_ld(&bar[XB_XGEN(b.x)]) == gen, bar);
            __builtin_amdgcn_fence(__ATOMIC_ACQUIRE, "agent");
            asm volatile("s_waitcnt vmcnt(0)" ::: "memory");
        }
    }
    __syncthreads();
}

struct Args { const float* in[31]; float* out; unsigned char* ws; };
enum { I_X = 0, I_C, I_WADA, I_BADA, I_GPRE1, I_GPOST1, I_W1G, I_W1U, I_W1D, I_GPREM, I_GPOSTM, I_WIN, I_SINKS, I_ARE, I_AIM, I_LSTEP, I_BRE, I_BIM, I_CRE, I_CIM, I_SSMD, I_WGLU, I_BGLU,
       I_GATT, I_GSSM, I_WOUT, I_GPRE2, I_GPOST2, I_W2G, I_W2U, I_W2D };

struct Frame {
    LAS unsigned char* lds; int tid, lane, wave, G;
};

template <int MAP, int BLK = 0> __device__ __forceinline__ void p0_transpose_item(const float* W, int K, int N, bf16* WT, LAS float* scr, int item, int lane) {
    const int nblk = N / 32, kb = item / nblk, nb = item % nblk, k0 = 64 * kb, n0 = 32 * nb;
    float wv[32];
#pragma unroll
    for (int i = 0; i < 32; ++i) wv[i] = W[(size_t)(k0 + 2 * i + (lane >> 5)) * N + n0 + (lane & 31)];
#pragma unroll
    for (int i = 0; i < 32; ++i) scr[(2 * i + (lane >> 5)) * 33 + (lane & 31)] = wv[i];
    LDS_WAIT(); asm volatile("" ::: "memory");
    const int c = lane & 7;
    const int r0 = (MAP == 0) ? n0 : ((n0 >> 7) * 256 + (n0 & 127) + (MAP == 2 ? 128 : 0));
#pragma unroll
    for (int j = 0; j < 4; ++j) { const int n = (lane >> 3) + 8 * j; const LAS float* s = scr + (8 * c) * 33 + n;
        v4u o; o.x = pk2(s[0 * 33], s[1 * 33]); o.y = pk2(s[2 * 33], s[3 * 33]); o.z = pk2(s[4 * 33], s[5 * 33]); o.w = pk2(s[6 * 33], s[7 * 33]);
        const int row = r0 + n;
        if (BLK) *(GAS v4u*)(WT + ((size_t)(row >> 8) * (K >> 6) + (k0 >> 6)) * 16384 + (row & 255) * 64 + 8 * c) = o;
        else *(GAS v4u*)(WT + (size_t)row * K + k0 + 8 * c) = o; }
    LDS_WAIT(); asm volatile("" ::: "memory");
}
__device__ __forceinline__ void p0_zero_slots(Frame& F, const Args& a) {
    int tid_l = F.wave * 64 + (int)__builtin_amdgcn_mbcnt_hi(~0u, __builtin_amdgcn_mbcnt_lo(~0u, 0u)); asm volatile("" : "+v"(tid_l)); const int lane_l = tid_l & 63;
    v4u* z = (v4u*)(a.ws + WS_XB);
    for (int i = blockIdx.x * NTHR + tid_l; i < 6 * M / 2; i += F.G * NTHR) z[i] = (v4u){0u, 0u, 0u, 0u};
}
template <int PART> __device__ __forceinline__ void p0_weights(Frame& F, const Args& a) {
    int tid_l = F.wave * 64 + (int)__builtin_amdgcn_mbcnt_hi(~0u, __builtin_amdgcn_mbcnt_lo(~0u, 0u)); asm volatile("" : "+v"(tid_l)); const int lane_l = tid_l & 63;
    LAS float* scr = (LAS float*)(F.lds + F.wave * 16384);
    int first, nblk;
    if (PART == 0) { first = (NMOD / 32 > F.G && NMOD / 32 < 2 * F.G) ? NMOD / 32 - F.G : 0; nblk = F.G - first; }
    else { const int busy = (M / 256) * (DIN / 256) - 2 * F.G; first = (busy > 0 && busy < F.G) ? busy : 0; nblk = F.G - first; }
    if ((int)blockIdx.x < first) return;
    const int gw = ((int)blockIdx.x - first) * NWAVES + F.wave, NGW = nblk * NWAVES;
    unsigned char* ws = a.ws;
    constexpr int I_GU = (DM / 64) * (DFF / 32), I_D = (DFF / 64) * (DM / 32), I_IN = (DM / 64) * (DIN / 32), I_GL = (DSSM / 64) * (DSSM / 32), I_O = (DM / 64) * (DM / 32);
    if (PART == 0) {
        constexpr int NITEMS = 2 * I_GU + I_D + I_IN;
        for (int it = gw; it < NITEMS; it += NGW) {
            int r = it;
            if (r < I_GU) { p0_transpose_item<1>(a.in[I_W1G], DM, DFF, (bf16*)(ws + WS_W1GU), scr, r, lane_l); continue; } r -= I_GU;
            if (r < I_GU) { p0_transpose_item<2>(a.in[I_W1U], DM, DFF, (bf16*)(ws + WS_W1GU), scr, r, lane_l); continue; } r -= I_GU;
            if (r < I_D) { p0_transpose_item<0, DOWN_BLK>(a.in[I_W1D], DFF, DM, (bf16*)(ws + WS_W1D), scr, r, lane_l); continue; } r -= I_D;
            p0_transpose_item<0>(a.in[I_WIN], DM, DIN, (bf16*)(ws + WS_WIN), scr, r, lane_l);
        }
    } else {
        constexpr int NITEMS = 2 * I_GU + I_D + I_GL + I_O;
        for (int it = gw; it < NITEMS; it += NGW) {
            int r = it;
            if (r < I_GU) { p0_transpose_item<1>(a.in[I_W2G], DM, DFF, (bf16*)(ws + WS_W2GU), scr, r, lane_l); continue; } r -= I_GU;
            if (r < I_GU) { p0_transpose_item<2>(a.in[I_W2U], DM, DFF, (bf16*)(ws + WS_W2GU), scr, r, lane_l); continue; } r -= I_GU;
            if (r < I_D) { p0_transpose_item<0, DOWN_BLK>(a.in[I_W2D], DFF, DM, (bf16*)(ws + WS_W2D), scr, r, lane_l); continue; } r -= I_D;
            if (r < I_GL) { p0_transpose_item<0>(a.in[I_WGLU], DSSM, DSSM, (bf16*)(ws + WS_WGLU), scr, r, lane_l); continue; } r -= I_GL;
            p0_transpose_item<0>(a.in[I_WOUT], DM, DM, (bf16*)(ws + WS_WOUT), scr, r, lane_l);
        }
    }
}
__device__ __forceinline__ void p0_mod(Frame& F, const Args& a) {
    int tid_l = F.wave * 64 + (int)__builtin_amdgcn_mbcnt_hi(~0u, __builtin_amdgcn_mbcnt_lo(~0u, 0u)); asm volatile("" : "+v"(tid_l)); const int lane_l = tid_l & 63;
    LAS float* cact = (LAS float*)F.lds;
    LAS float* red = (LAS float*)(F.lds + 81920);
    const float* c = a.in[I_C]; const float* W = a.in[I_WADA]; const float* bias = a.in[I_BADA]; float* mod = (float*)(a.ws + WS_MOD);
    {
        float cv[32];
#pragma unroll
        for (int j = 0; j < 32; ++j) cv[j] = c[j * NTHR + tid_l];
#pragma unroll
        for (int j = 0; j < 32; ++j) { const int i = j * NTHR + tid_l, b = i >> 10, k = i & 1023; const float v = cv[j]; cact[k * 20 + b] = v / (1.0f + __expf(-v)); }
    }
    __syncthreads();
    const int cg = lane_l & 7, rg = lane_l >> 3;
    for (int tile = blockIdx.x; tile < NMOD / 32; tile += 2 * F.G) {
        const int tileB = tile + F.G; const bool hasB = tileB < NMOD / 32;
        f32x4 w[2][16];
        { const float* wp = W + (size_t)(F.wave * 128 + rg) * NMOD + tile * 32 + 4 * cg;
#pragma unroll
          for (int i = 0; i < 16; ++i) w[0][i] = *(const f32x4*)(wp + (size_t)i * 8 * NMOD); }
        if (hasB) { const float* wp = W + (size_t)(F.wave * 128 + rg) * NMOD + tileB * 32 + 4 * cg;
#pragma unroll
          for (int i = 0; i < 16; ++i) w[1][i] = *(const f32x4*)(wp + (size_t)i * 8 * NMOD); }
#pragma unroll
        for (int t = 0; t < 2; ++t) {
            if (t == 1 && !hasB) break;
            const int n0 = (t == 0 ? tile : tileB) * 32;
            f32x4 acc[16];
#pragma unroll
            for (int b = 0; b < 16; ++b) acc[b] = (f32x4){0.f, 0.f, 0.f, 0.f};
#pragma unroll
            for (int i = 0; i < 16; ++i) {
                const LAS f32x4* cp = (const LAS f32x4*)(cact + (F.wave * 128 + i * 8 + rg) * 20);
                const f32x4 c0 = cp[0], c1 = cp[1], c2 = cp[2], c3 = cp[3]; const f32x4 wv = w[t][i];
                acc[0] += wv * c0[0]; acc[1] += wv * c0[1]; acc[2] += wv * c0[2]; acc[3] += wv * c0[3];
                acc[4] += wv * c1[0]; acc[5] += wv * c1[1]; acc[6] += wv * c1[2]; acc[7] += wv * c1[3];
                acc[8] += wv * c2[0]; acc[9] += wv * c2[1]; acc[10] += wv * c2[2]; acc[11] += wv * c2[3];
                acc[12] += wv * c3[0]; acc[13] += wv * c3[1]; acc[14] += wv * c3[2]; acc[15] += wv * c3[3];
            }
            f32x4 s8[8], s4[4], s2[2];
            { const bool up = (lane_l & 32) != 0;
#pragma unroll
              for (int i = 0; i < 8; ++i) { const f32x4 keep = up ? acc[8 + i] : acc[i], send = up ? acc[i] : acc[8 + i]; f32x4 rcv;
#pragma unroll
                  for (int e = 0; e < 4; ++e) rcv[e] = __shfl_xor(send[e], 32);
                  s8[i] = keep + rcv; } }
            { const bool up = (lane_l & 16) != 0;
#pragma unroll
              for (int i = 0; i < 4; ++i) { const f32x4 keep = up ? s8[4 + i] : s8[i], send = up ? s8[i] : s8[4 + i]; f32x4 rcv;
#pragma unroll
                  for (int e = 0; e < 4; ++e) rcv[e] = __shfl_xor(send[e], 16);
                  s4[i] = keep + rcv; } }
            { const bool up = (lane_l & 8) != 0;
#pragma unroll
              for (int i = 0; i < 2; ++i) { const f32x4 keep = up ? s4[2 + i] : s4[i], send = up ? s4[i] : s4[2 + i]; f32x4 rcv;
#pragma unroll
                  for (int e = 0; e < 4; ++e) rcv[e] = __shfl_xor(send[e], 8);
                  s2[i] = keep + rcv; } }
            { const int b0 = ((lane_l >> 5) & 1) * 8 + ((lane_l >> 4) & 1) * 4 + ((lane_l >> 3) & 1) * 2;
#pragma unroll
              for (int i = 0; i < 2; ++i) *(LAS f32x4*)(red + (F.wave * 16 + b0 + i) * 32 + 4 * cg) = s2[i]; }
            __syncthreads();
            { const int b = tid_l >> 5, n = tid_l & 31; float s = bias[n0 + n];
#pragma unroll
              for (int wv = 0; wv < 8; ++wv) s += red[(wv * 16 + b) * 32 + n];
              mod[(size_t)b * NMOD + n0 + n] = s; }
            __syncthreads();
        }
    }
}
__device__ __forceinline__ void p0_ssm(Frame& F, const Args& a) {
    int tid_l = F.wave * 64 + (int)__builtin_amdgcn_mbcnt_hi(~0u, __builtin_amdgcn_mbcnt_lo(~0u, 0u)); asm volatile("" : "+v"(tid_l)); const int lane_l = tid_l & 63;
    LAS float* pwr = (LAS float*)F.lds;
    LAS float* pwi = pwr + 17 * 64;
    LAS float* cfr = pwi + 17 * 64;
    LAS float* cfi = cfr + 64;
    LAS float* cre = cfi + 64;
    LAS float* cim = cre + 1024;
    LAS float* bbr = cim + 1024;
    LAS float* bbi = bbr + 1024;
    const float* a_re = a.in[I_ARE]; const float* a_im = a.in[I_AIM]; const float* lstep = a.in[I_LSTEP];
    const float* b_re = a.in[I_BRE]; const float* b_im = a.in[I_BIM]; const float* c_re = a.in[I_CRE]; const float* c_im = a.in[I_CIM]; const float* dsk = a.in[I_SSMD];
    bf16* Tw = (bf16*)(a.ws + WS_TW); bf16* WS = (bf16*)(a.ws + WS_WS); float* Kt = (float*)(a.ws + WS_KT); float* A16 = (float*)(a.ws + WS_A16);
    for (int wi = blockIdx.x; wi < 256; wi += F.G) {
        const int g = wi >> 3, tp = wi & 7;
        __syncthreads();
        for (int i = tid_l; i < 1024; i += NTHR) { cre[i] = c_re[g * 1024 + i]; cim[i] = c_im[g * 1024 + i]; bbr[i] = b_re[g * 1024 + i]; bbi[i] = b_im[g * 1024 + i]; }
        const float dt = expf(lstep[g]);
        for (int i = tid_l; i < 17 * 64; i += NTHR) { const int tau = i >> 6, p = i & 63; const float are = a_re[g * 64 + p], aim = a_im[g * 64 + p];
            const float mag = expf(are * dt * (float)tau); float s, c; sincosf(aim * dt * (float)tau, &s, &c); pwr[i] = mag * c; pwi[i] = mag * s; }
        if (tid_l < 64) { const int p = tid_l; const float are = a_re[g * 64 + p], aim = a_im[g * 64 + p];
            const float mag = expf(are * dt); float s, c; sincosf(aim * dt, &s, &c); const float lr = mag * c - 1.0f, li = mag * s, den = are * are + aim * aim;
            cfr[p] = (lr * are + li * aim) / den; cfi[p] = (li * are - lr * aim) / den; }
        __syncthreads();
        for (int i = tid_l; i < 1024; i += NTHR) { const int p = i >> 4; const float br = bbr[i], bi = bbi[i]; bbr[i] = cfr[p] * br - cfi[p] * bi; bbi[i] = cfr[p] * bi + cfi[p] * br; }
        __syncthreads();
        {
            const int tau = 2 * tp + (tid_l >> 8), h = (tid_l >> 4) & 15, hp = tid_l & 15; float acc = 0.f;
#pragma unroll 8
            for (int p = 0; p < 64; ++p) {
                const float cr = cre[h * 64 + p], ci = cim[h * 64 + p], br = bbr[p * 16 + hp], bi = bbi[p * 16 + hp];
                const float pr = pwr[tau * 64 + p], pi = pwi[tau * 64 + p];
                const float wr_ = pr * br - pi * bi, wi_ = pr * bi + pi * br;
                acc += cr * wr_ - ci * wi_; }
            if (tau == 0 && h == hp) acc += dsk[g * 16 + h];
            Kt[((g * 16 + tau) * 16 + h) * 16 + hp] = acc;
        }
        for (int e = tid_l; e < 2048; e += NTHR) {
            const int i = 2 * tp + (e >> 10), h = (e >> 6) & 15, p = e & 63;
            const float cr = cre[h * 64 + p], ci = cim[h * 64 + p], pr = pwr[(i + 1) * 64 + p], pi = pwi[(i + 1) * 64 + p];
            bf16* row = Tw + (size_t)(g * 256 + i * 16 + h) * KSS;
            row[256 + p] = (bf16)f2bf(cr * pr - ci * pi); row[320 + p] = (bf16)f2bf(-(cr * pi + ci * pr)); }
        for (int e = tid_l; e < 2048; e += NTHR) {
            const int j = 2 * tp + (e >> 10), p = (e >> 4) & 63, hp = e & 15;
            const float br = bbr[p * 16 + hp], bi = bbi[p * 16 + hp];
            const float pr = pwr[(15 - j) * 64 + p], pi = pwi[(15 - j) * 64 + p];
            WS[(size_t)(g * 128 + p) * 256 + j * 16 + hp] = (bf16)f2bf(pr * br - pi * bi);
            WS[(size_t)(g * 128 + 64 + p) * 256 + j * 16 + hp] = (bf16)f2bf(pr * bi + pi * br); }
        if (tp == 0 && tid_l < 64) { A16[g * 64 + tid_l] = pwr[16 * 64 + tid_l]; A16[NGRP * 64 + g * 64 + tid_l] = pwi[16 * 64 + tid_l]; }
    }
    __syncthreads();
}
__device__ __forceinline__ void p1_toeplitz(Frame& F, const Args& a) {
    int tid_l = F.wave * 64 + (int)__builtin_amdgcn_mbcnt_hi(~0u, __builtin_amdgcn_mbcnt_lo(~0u, 0u)); asm volatile("" : "+v"(tid_l)); const int lane_l = tid_l & 63;
    const float* Kt = (const float*)(a.ws + WS_KT); bf16* Tw = (bf16*)(a.ws + WS_TW);
    for (int it = blockIdx.x * NTHR + tid_l; it < NGRP * 256 * 32; it += F.G * NTHR) {
        const int g = it >> 13, r = (it >> 5) & 255, jc = it & 31, i = r >> 4, h = r & 15, j = jc >> 1, hp0 = (jc & 1) * 8;
        v4u o = (v4u){0u, 0u, 0u, 0u};
        if (j <= i) { const float* k = Kt + ((g * 16 + (i - j)) * 16 + h) * 16 + hp0; const f32x4 k0 = *(const f32x4*)k, k1 = *(const f32x4*)(k + 4);
            o.x = pk2(k0[0], k0[1]); o.y = pk2(k0[2], k0[3]); o.z = pk2(k1[0], k1[1]); o.w = pk2(k1[2], k1[3]); }
        *(v4u*)(Tw + (size_t)(g * 256 + r) * KSS + j * 16 + hp0) = o;
    }
}
__device__ __forceinline__ void rows_norm_mod(Frame& F, const float* x, const float* g, const float* sh, const float* sc, bf16* H) {
    int tid_l = F.wave * 64 + (int)__builtin_amdgcn_mbcnt_hi(~0u, __builtin_amdgcn_mbcnt_lo(~0u, 0u)); asm volatile("" : "+v"(tid_l)); const int lane_l = tid_l & 63;
    const int gw = blockIdx.x * NWAVES + F.wave, NGW = F.G * NWAVES;
    for (int m = 2 * gw; m < M; m += 2 * NGW) {
        const int b = m >> 11; const f32x4* xr = (const f32x4*)(x + (size_t)m * DM) + lane_l;
        f32x4 v[2][4]; float s0 = 0.f, s1 = 0.f;
#pragma unroll
        for (int j = 0; j < 4; ++j) { v[0][j] = xr[64 * j]; v[1][j] = xr[256 + 64 * j]; }
#pragma unroll
        for (int j = 0; j < 4; ++j) { s0 += (v[0][j][0] * v[0][j][0] + v[0][j][1] * v[0][j][1]) + (v[0][j][2] * v[0][j][2] + v[0][j][3] * v[0][j][3]);
                                      s1 += (v[1][j][0] * v[1][j][0] + v[1][j][1] * v[1][j][1]) + (v[1][j][2] * v[1][j][2] + v[1][j][3] * v[1][j][3]); }
        const float r0 = 1.0f / sqrtf(wave_sum(s0) * (1.0f / DM) + EPS), r1 = 1.0f / sqrtf(wave_sum(s1) * (1.0f / DM) + EPS);
        v2u* o8 = (v2u*)(H + (size_t)m * DM) + lane_l;
#pragma unroll
        for (int j = 0; j < 4; ++j) { const int col = 4 * lane_l + 256 * j;
            const f32x4 g4 = *(const f32x4*)(g + col) * (1.0f + *(const f32x4*)(sc + (size_t)b * NMOD + col)), h4 = *(const f32x4*)(sh + (size_t)b * NMOD + col);
            const f32x4 o0 = v[0][j] * r0 * g4 + h4, o1 = v[1][j] * r1 * g4 + h4;
            o8[64 * j] = (v2u){pk2(o0[0], o0[1]), pk2(o0[2], o0[3])}; o8[256 + 64 * j] = (v2u){pk2(o1[0], o1[1]), pk2(o1[2], o1[3])}; }
    }
}
template <bool NORM> __device__ __forceinline__ void rows_residual(Frame& F, const float* xin, float* xout, const bf16* f, const float* fss, float coef, const float* ga, const float* gpost,
                                                                    const float* gpre, const float* sh, const float* sc, bf16* H) {
    int tid_l = F.wave * 64 + (int)__builtin_amdgcn_mbcnt_hi(~0u, __builtin_amdgcn_mbcnt_lo(~0u, 0u)); asm volatile("" : "+v"(tid_l)); const int lane_l = tid_l & 63;
    const int gw = blockIdx.x * NWAVES + F.wave, NGW = F.G * NWAVES;
    for (int m = gw; m < M; m += NGW) {
        const int b = m >> 11; const f32x4* xr = (const f32x4*)(xin + (size_t)m * DM) + lane_l; const v2u* fr = (const v2u*)(f + (size_t)m * DM) + lane_l;
        float q = (lane_l < 16) ? fss[(size_t)m * 16 + lane_l] : 0.f; q = wave_sum(q);
        const float rf = coef / sqrtf(q * (1.0f / DM) + EPS);
        f32x4 v[4]; float s = 0.f;
#pragma unroll
        for (int j = 0; j < 4; ++j) { const int col = 4 * lane_l + 256 * j; const f32x4 xv = xr[64 * j]; const v2u fw = fr[64 * j];
            const f32x4 ga4 = *(const f32x4*)(ga + (size_t)b * NMOD + col), gp4 = *(const f32x4*)(gpost + col);
            const f32x4 fv = (f32x4){bflo(fw.x), bfhi(fw.x), bflo(fw.y), bfhi(fw.y)};
            v[j] = xv + ga4 * gp4 * fv * rf;
            s += (v[j][0] * v[j][0] + v[j][1] * v[j][1]) + (v[j][2] * v[j][2] + v[j][3] * v[j][3]); }
        f32x4* xo = (f32x4*)(xout + (size_t)m * DM) + lane_l;
#pragma unroll
        for (int j = 0; j < 4; ++j) xo[64 * j] = v[j];
        if (NORM) {
            const float rstd = 1.0f / sqrtf(wave_sum(s) * (1.0f / DM) + EPS);
            v2u* o8 = (v2u*)(H + (size_t)m * DM) + lane_l;
#pragma unroll
            for (int j = 0; j < 4; ++j) { const int col = 4 * lane_l + 256 * j;
                const f32x4 g4 = *(const f32x4*)(gpre + col), s4 = *(const f32x4*)(sc + (size_t)b * NMOD + col), h4 = *(const f32x4*)(sh + (size_t)b * NMOD + col);
                const f32x4 o = v[j] * rstd * g4 * (1.0f + s4) + h4;
                o8[64 * j] = (v2u){pk2(o[0], o[1]), pk2(o[2], o[3])}; }
        }
    }
}
__device__ __forceinline__ void rows_ssm_norm(Frame& F, const bf16* sr, const float* sss, const float* g, bf16* MX) {
    int tid_l = F.wave * 64 + (int)__builtin_amdgcn_mbcnt_hi(~0u, __builtin_amdgcn_mbcnt_lo(~0u, 0u)); asm volatile("" : "+v"(tid_l)); const int lane_l = tid_l & 63;
    const int gw = blockIdx.x * NWAVES + F.wave, NGW = F.G * NWAVES;
    for (int m = gw; m < M; m += NGW) {
        float q = (lane_l < 8) ? sss[(size_t)m * 8 + lane_l] : 0.f; q = wave_sum(q);
        const float r = 1.0f / sqrtf(q * (1.0f / DSSM) + EPS);
        const v4u w = *((const v4u*)(sr + (size_t)m * DSSM) + lane_l);
        const f32x4 g0 = *(const f32x4*)(g + 8 * lane_l), g1 = *(const f32x4*)(g + 8 * lane_l + 4);
        v4u o; o.x = pk2(bflo(w.x) * r * g0[0], bfhi(w.x) * r * g0[1]); o.y = pk2(bflo(w.y) * r * g0[2], bfhi(w.y) * r * g0[3]);
        o.z = pk2(bflo(w.z) * r * g1[0], bfhi(w.z) * r * g1[1]); o.w = pk2(bflo(w.w) * r * g1[2], bfhi(w.w) * r * g1[3]);
        *((v4u*)(MX + (size_t)m * DM + DATT) + lane_l) = o;
    }
}
constexpr int SS_WS = 0, SS_WROW = 528, SS_S = 128 * SS_WROW;
__device__ __forceinline__ void ssm_state_scan(Frame& F, const Args& a) {
    int tid_l = F.wave * 64 + (int)__builtin_amdgcn_mbcnt_hi(~0u, __builtin_amdgcn_mbcnt_lo(~0u, 0u)); asm volatile("" : "+v"(tid_l)); const int lane_l = tid_l & 63;
    bf16* As = (bf16*)(a.ws + WS_AS); const bf16* WS = (const bf16*)(a.ws + WS_WS); const float* A16 = (const float*)(a.ws + WS_A16);
    const int r = lane_l & 31, h = lane_l >> 5, rt = F.wave >> 1, ct0 = 2 * (F.wave & 1);
    LAS float* SlA = (LAS float*)(F.lds + SS_S); LAS float* SlB = (LAS float*)(F.lds + SS_WS);
    for (int item = blockIdx.x; item < NGRP * (NB / 2); item += F.G) {
        const int g = item & 31, b0 = 2 * (item >> 5);
        __syncthreads();
        f32x16 accA[2], accB[2];
        {
            v4u wv[8];
#pragma unroll
            for (int it = 0; it < 8; ++it) { const int id = it * NTHR + tid_l; wv[it] = *(const v4u*)(WS + (size_t)(g * 128 + (id >> 5)) * 256 + (id & 31) * 8); }
            bf16x8 afA[16], afB[16];
            const bf16* ap = As + (size_t)(g * 2048 + b0 * 128 + rt * 32 + r) * KSS + 8 * h;
#pragma unroll
            for (int kk = 0; kk < 16; ++kk) afA[kk] = *(const bf16x8*)(ap + kk * 16);
#pragma unroll
            for (int kk = 0; kk < 16; ++kk) afB[kk] = *(const bf16x8*)(ap + (size_t)128 * KSS + kk * 16);
#pragma unroll
            for (int it = 0; it < 8; ++it) { const int id = it * NTHR + tid_l; *(LAS v4u*)(F.lds + SS_WS + (id >> 5) * SS_WROW + (id & 31) * 16) = wv[it]; }
            __syncthreads();
#pragma unroll
            for (int t = 0; t < 2; ++t)
#pragma unroll
                for (int e = 0; e < 16; ++e) { accA[t][e] = 0.f; accB[t][e] = 0.f; }
#pragma unroll
            for (int kk = 0; kk < 16; ++kk)
#pragma unroll
                for (int t = 0; t < 2; ++t) { const bf16x8 bfr = *(const LAS bf16x8*)(F.lds + SS_WS + ((ct0 + t) * 32 + r) * SS_WROW + (kk * 16 + 8 * h) * 2);
                    accA[t] = __builtin_amdgcn_mfma_f32_32x32x16_bf16(afA[kk], bfr, accA[t], 0, 0, 0);
                    accB[t] = __builtin_amdgcn_mfma_f32_32x32x16_bf16(afB[kk], bfr, accB[t], 0, 0, 0); }
        }
#pragma unroll
        for (int t = 0; t < 2; ++t)
#pragma unroll
            for (int e = 0; e < 16; ++e) { const int row = (e & 3) + 8 * (e >> 2) + 4 * h; SlA[(rt * 32 + row) * 128 + (ct0 + t) * 32 + r] = accA[t][e]; }
        __syncthreads();
#pragma unroll
        for (int t = 0; t < 2; ++t)
#pragma unroll
            for (int e = 0; e < 16; ++e) { const int row = (e & 3) + 8 * (e >> 2) + 4 * h; SlB[(rt * 32 + row) * 128 + (ct0 + t) * 32 + r] = accB[t][e]; }
        __syncthreads();
        if (F.wave < 2) {
            const int p = lane_l, b = b0 + F.wave; const LAS float* Sl = F.wave ? SlB : SlA;
            const float ar = A16[g * 64 + p], ai = A16[NGRP * 64 + g * 64 + p];
            float xr = 0.f, xi = 0.f; bf16* xp = As + (size_t)(g * 2048 + b * 128) * KSS + 256 + p;
#pragma unroll 8
            for (int c = 0; c < 128; ++c) {
                xp[(size_t)c * KSS] = (bf16)f2bf(xr); xp[(size_t)c * KSS + 64] = (bf16)f2bf(xi);
                const float sr = Sl[c * 128 + p], si = Sl[c * 128 + 64 + p];
                const float nr = ar * xr - ai * xi + sr, ni = ar * xi + ai * xr + si; xr = nr; xi = ni; }
        }
    }
    __syncthreads();
}
#ifdef ATT_STAMPS
#define ATT_STAMP(k) do { if (blockIdx.x == 0 && tid_l == 0) ((volatile LAS unsigned*)(F.lds + LDS_MISC_OFF + 64))[48 + (k)] = (unsigned)__builtin_amdgcn_s_memrealtime(); } while (0)
#else
#define ATT_STAMP(k) do {} while (0)
#endif
constexpr int AT_K = 0, AT_VT = 65536, AT_VTH = 33280  , AT_X = AT_VT + 2 * AT_VTH  ;
__device__ __forceinline__ void attn_phase(Frame& F, const Args& a) {
    int tid_l = F.wave * 64 + (int)__builtin_amdgcn_mbcnt_hi(~0u, __builtin_amdgcn_mbcnt_lo(~0u, 0u)); asm volatile("" : "+v"(tid_l)); const int lane_l = tid_l & 63;
    const bf16* Qg = (const bf16*)(a.ws + WS_Q); const bf16* Kg = (const bf16*)(a.ws + WS_K); const bf16* Vg = (const bf16*)(a.ws + WS_V); bf16* MX = (bf16*)(a.ws + WS_H);
    const float* sinks = a.in[I_SINKS]; const float* gat = a.in[I_GATT];
    const int hq = F.wave, kvh = hq >> 2;
    const float slope2 = exp2f(-(float)(hq + 1)) * pg8::LOG2E, sink2 = sinks[hq] * pg8::LOG2E, qscale = 0.125f * pg8::LOG2E;
    LAS float* xch = (LAS float*)(F.lds + AT_X);
    for (int unit = blockIdx.x; unit < NB * (SEQ / 128); unit += F.G) {
        const int b = unit >> 4, nb = unit & 15; const size_t tok0 = (size_t)b * SEQ + (size_t)nb * 128;
        ATT_STAMP(0);
        int tl = tid_l; asm volatile("" : "+v"(tl)); const int r = tl & 31, h = (tl >> 5) & 1;
        __syncthreads();
        {
            v4u kv[8], vv[8];
            const int cc0 = tl & 15, kj0 = tl >> 4;
            const bf16* kp = Kg + (tok0 - 128 + kj0) * 128 + cc0 * 8; const bf16* vp = Vg + (tok0 - 128 + kj0) * 128 + cc0 * 8;
#pragma unroll
            for (int it = 0; it < 8; ++it) {
                kv[it] = (v4u){0u, 0u, 0u, 0u}; vv[it] = (v4u){0u, 0u, 0u, 0u};
                if (nb > 0 || it >= 4) { kv[it] = *(const v4u*)kp; vv[it] = *(const v4u*)vp; }
                kp += 32 * 128; vp += 32 * 128; asm volatile("" : "+v"(kp), "+v"(vp)); }
#pragma unroll
            for (int it = 0; it < 8; ++it) { const int id = it * NTHR + tl, kj = id >> 4, cc = id & 15, kh = cc >> 3, c = cc & 7;
                *(LAS v4u*)(F.lds + AT_K + kh * 32768 + kj * 128 + ((c ^ (kj & 7)) << 4)) = kv[it];
                LAS unsigned short* vt = (LAS unsigned short*)(F.lds + AT_VT + kh * AT_VTH + (c * 8) * 520) + kj; const v4u v = vv[it];
                vt[0 * 260] = (unsigned short)(v.x & 0xffffu); vt[1 * 260] = (unsigned short)(v.x >> 16); vt[2 * 260] = (unsigned short)(v.y & 0xffffu); vt[3 * 260] = (unsigned short)(v.y >> 16);
                vt[4 * 260] = (unsigned short)(v.z & 0xffffu); vt[5 * 260] = (unsigned short)(v.z >> 16); vt[6 * 260] = (unsigned short)(v.w & 0xffffu); vt[7 * 260] = (unsigned short)(v.w >> 16); }
        }
        bf16x8 qf[4];
        { const bf16* qp = Qg + (tok0 + r) * DATT + hq * 64 + 8 * h;
#pragma unroll
          for (int s4 = 0; s4 < 4; ++s4) qf[s4] = *(const bf16x8*)(qp + 16 * s4); }
        __syncthreads();
        ATT_STAMP(1);
        const LAS unsigned char* Kl = F.lds + AT_K + kvh * 32768; const LAS unsigned char* Vl = F.lds + AT_VT + kvh * AT_VTH;
#pragma unroll 1
        for (int qt = 0; qt < 4; ++qt) {
            f32x16 sc[5];
            float rb = -slope2 * (float)(r - 4 * h); asm volatile("" : "+v"(rb));
#pragma unroll
            for (int t5 = 0; t5 < 5; ++t5) {
#pragma unroll
                for (int e = 0; e < 16; ++e) sc[t5][e] = rb - slope2 * (float)(128 - 32 * t5 - ((e & 3) + 8 * (e >> 2)));
                const int key = 32 * (qt + t5) + r;
#pragma unroll
                for (int s4 = 0; s4 < 4; ++s4) { const bf16x8 kf = *(const LAS bf16x8*)(Kl + key * 128 + (((2 * s4 + h) ^ (key & 7)) << 4));
                    sc[t5] = __builtin_amdgcn_mfma_f32_32x32x16_bf16(kf, qf[s4], sc[t5], 0, 0, 0); }
            }
            if (qt < 3) { const bf16* qp = Qg + (tok0 + 32 * (qt + 1) + r) * DATT + hq * 64 + 8 * h;
#pragma unroll
                for (int s4 = 0; s4 < 4; ++s4) qf[s4] = *(const bf16x8*)(qp + 16 * s4); }
            float mx = sink2;
#pragma unroll
            for (int e = 0; e < 16; ++e) { const int koff = (e & 3) + 8 * (e >> 2) + 4 * h;
                sc[0][e] = (koff > r) ? sc[0][e] : -1e30f; sc[4][e] = (koff <= r) ? sc[4][e] : -1e30f; }
            if (nb == 0) {
#pragma unroll
                for (int t5 = 0; t5 < 4; ++t5) if (qt + t5 < 4) {
#pragma unroll
                    for (int e = 0; e < 16; ++e) sc[t5][e] = -1e30f; }
            }
#pragma unroll
            for (int t5 = 0; t5 < 5; ++t5)
#pragma unroll
                for (int e = 0; e < 16; e += 2) mx = fmaxf(fmaxf(mx, sc[t5][e]), sc[t5][e + 1]);
            mx = fmaxf(mx, __shfl_xor(mx, 32));
            float sum = 0.f;
#pragma unroll
            for (int t5 = 0; t5 < 5; ++t5)
#pragma unroll
                for (int e = 0; e < 16; ++e) { const float pv = __builtin_amdgcn_exp2f(sc[t5][e] - mx); sc[t5][e] = pv; sum += pv; }
            sum += __shfl_xor(sum, 32);
            const float inv = 1.0f / (sum + __builtin_amdgcn_exp2f(sink2 - mx));
            f32x16 o[2];
#pragma unroll
            for (int dt = 0; dt < 2; ++dt)
#pragma unroll
                for (int e = 0; e < 16; ++e) o[dt][e] = 0.f;
#pragma unroll
            for (int t5 = 0; t5 < 5; ++t5)
#pragma unroll
                for (int s2 = 0; s2 < 2; ++s2) {
                    v4u pw; pw.x = pk2(sc[t5][8 * s2 + 0], sc[t5][8 * s2 + 1]); pw.y = pk2(sc[t5][8 * s2 + 2], sc[t5][8 * s2 + 3]);
                    pw.z = pk2(sc[t5][8 * s2 + 4], sc[t5][8 * s2 + 5]); pw.w = pk2(sc[t5][8 * s2 + 6], sc[t5][8 * s2 + 7]);
                    const bf16x8 pf = __builtin_bit_cast(bf16x8, pw);
                    const int key0 = 32 * (qt + t5) + 16 * s2 + 4 * h;
#pragma unroll
                    for (int dt = 0; dt < 2; ++dt) { const LAS unsigned char* vp = Vl + (dt * 32 + r) * 520 + key0 * 2;
                        const v2u lo = *(const LAS v2u*)vp, hi = *(const LAS v2u*)(vp + 16);
                        const v4u vw = (v4u){lo.x, lo.y, hi.x, hi.y};
                        o[dt] = __builtin_amdgcn_mfma_f32_32x32x16_bf16(__builtin_bit_cast(bf16x8, vw), pf, o[dt], 0, 0, 0); }
                }
            float ssq = 0.f;
#pragma unroll
            for (int dt = 0; dt < 2; ++dt)
#pragma unroll
                for (int e = 0; e < 16; ++e) { o[dt][e] *= inv; ssq += o[dt][e] * o[dt][e]; }
            ssq += __shfl_xor(ssq, 32);
            LAS float* xb = xch + (qt & 1) * 256;
            if (h == 0) xb[r * 8 + hq] = ssq;
            __syncthreads();
            const f32x4 t0 = *(const LAS f32x4*)(xb + r * 8), t1 = *(const LAS f32x4*)(xb + r * 8 + 4);
            const float tot = ((t0[0] + t0[1]) + (t0[2] + t0[3])) + ((t1[0] + t1[1]) + (t1[2] + t1[3]));
            const float rn = 1.0f / sqrtf(tot * (1.0f / DATT) + EPS);
            bf16* op = MX + (tok0 + 32 * qt + r) * DM + hq * 64 + 4 * h;
            const float* gp = gat + hq * 64; asm volatile("" : "+s"(gp));
#pragma unroll
            for (int dt = 0; dt < 2; ++dt)
#pragma unroll
                for (int k4 = 0; k4 < 4; ++k4) { const f32x4 g4 = *(const f32x4*)(gp + dt * 32 + 8 * k4 + 4 * h);
                    const v2u w = (v2u){pk2(o[dt][4 * k4 + 0] * rn * g4[0], o[dt][4 * k4 + 1] * rn * g4[1]), pk2(o[dt][4 * k4 + 2] * rn * g4[2], o[dt][4 * k4 + 3] * rn * g4[3])};
                    *(v2u*)(op + dt * 32 + 8 * k4) = w; }
            if (qt == 0) ATT_STAMP(2); if (qt == 3) ATT_STAMP(3);
        }
    }
    __syncthreads();
}
#ifndef REP0
#define REP0 1
#endif
#ifndef REP1
#define REP1 1
#endif
#ifndef REP2
#define REP2 1
#endif
#ifndef REP3
#define REP3 1
#endif
#ifndef REP4
#define REP4 1
#endif
#ifndef REP5
#define REP5 1
#endif
#ifndef REP6
#define REP6 1
#endif
#ifndef REP7
#define REP7 1
#endif
#ifndef REP8
#define REP8 1
#endif
#ifndef REP9
#define REP9 1
#endif
#ifndef REP10
#define REP10 1
#endif
#ifndef REP11
#define REP11 1
#endif
#ifndef REP12
#define REP12 1
#endif
#ifndef REP13
#define REP13 1
#endif
#ifndef REP14
#define REP14 1
#endif
#ifndef REP15
#define REP15 1
#endif
#ifndef GU_ALIGN
#define GU_ALIGN true
#endif
#ifndef GU_SP2
#define GU_SP2 true
#endif
#ifndef EPI_DBG1
#define EPI_DBG1 0
#endif
#ifndef EPI_DBG2
#define EPI_DBG2 0
#endif
#ifndef EPI_DBG3
#define EPI_DBG3 0
#endif
#ifndef GU_WGM
#define GU_WGM 8
#endif
#ifndef DOWN_REV
#define DOWN_REV 0
#endif
#ifndef XSYNC
#define XSYNC 0
#endif
__global__ void __launch_bounds__(NTHR, 2) fwd_megakernel(Args args) {
    extern __shared__ __attribute__((aligned(16))) unsigned char lds_raw[];
    Frame F; F.lds = (LAS unsigned char*)lds_raw; F.tid = threadIdx.x; F.lane = F.tid & 63; F.wave = __builtin_amdgcn_readfirstlane(F.tid >> 6); F.G = gridDim.x;
    unsigned char* ws = args.ws; unsigned* ctl = (unsigned*)(ws + WS_CTL);
    { volatile LAS unsigned* misc = (volatile LAS unsigned*)(F.lds + LDS_MISC_OFF); if (F.tid < 128) misc[F.tid] = 0u; }
    __syncthreads();
    const XcdBarrier bar = xcd_barrier_post((unsigned*)(ws + WS_CTL) + CW_BAR, (volatile LAS unsigned*)(F.lds + LDS_MISC_OFF) + 8);
#ifdef STAMP_A
    volatile LAS unsigned* tsl = (volatile LAS unsigned*)(F.lds + LDS_MISC_OFF + 64); int n_stamp = 0;
#define STAMP() do { if (blockIdx.x == 0 && F.tid == 0) { tsl[n_stamp] = (unsigned)__builtin_amdgcn_s_memrealtime(); tsl[16 + n_stamp] = (unsigned)__builtin_amdgcn_s_memtime(); } ++n_stamp; } while (0)
#else
#define STAMP() do {} while (0)
#endif
#ifdef SUBSTAMPS
#define SUBSTAMP() STAMP()
#else
#define SUBSTAMP() do {} while (0)
#endif
    STAMP();
    const float* mod = (const float*)(ws + WS_MOD);
    bf16* H = (bf16*)(ws + WS_H); bf16* ACT = (bf16*)(ws + WS_ACT); bf16* Fb = (bf16*)(ws + WS_F); float* FSS = (float*)(ws + WS_FSS); float* SSS = (float*)(ws + WS_SSS);
    const float* x = args.in[I_X]; float* out = args.out;

    for (int rep_ = 0; rep_ < REP0; ++rep_) { if (rep_) xcd_barrier(bar);
    p0_zero_slots(F, args);
    p0_mod(F, args); __syncthreads();
    p0_ssm(F, args); __syncthreads();
    p0_weights<0>(F, args);
    }
    xcd_barrier(bar); STAMP();
    for (int rep_ = 0; rep_ < REP1; ++rep_) { if (rep_) xcd_barrier(bar);
    rows_norm_mod(F, x, args.in[I_GPRE1], mod + 0 * DM, mod + 1 * DM, H);
    p1_toeplitz(F, args);
    }
    xcd_barrier(bar); STAMP();
    for (int rep_ = 0; rep_ < REP2; ++rep_) { if (rep_) xcd_barrier(bar);
    { pg8::Gemm g{H, (const bf16*)(ws + WS_W1GU), M, 2 * DFF, DM}; pg8::StaticOrder S; S.init(M, 2 * DFF, F.G, (int)blockIdx.x, GU_WGM);
      pg8::EpiSwiGLU E{ACT, DFF, DOWN_BLK}; pg8::gemm_phase<pg8::EpiSwiGLU, pg8::StaticOrder, GU_ALIGN, GU_SP2>(F.lds, g, S, E, F.wave); }
    }
    xcd_barrier(bar); STAMP();
    for (int rep_ = 0; rep_ < REP3; ++rep_) { if (rep_) xcd_barrier(bar);
    { pg8::Gemm g{ACT, (const bf16*)(ws + WS_W1D), M, DM, DFF, DOWN_BLK, DOWN_BLK}; pg8::StaticOrder S; S.init(M, DM, F.G, (int)blockIdx.x, 8, DOWN_REV);
      pg8::EpiResNorm<true> E{x, out, H, mod + 2 * DM, args.in[I_GPOST1], args.in[I_GPREM], mod + 3 * DM, mod + 4 * DM, NMOD, pg8::RowStats{(unsigned long long*)(ws + WS_XB) + 0 * (size_t)M, ctl + CW_TMO, 4, 1.0f / DM, EPS, 0.5f}, pg8::RowStats{(unsigned long long*)(ws + WS_XB) + 1 * (size_t)M, ctl + CW_TMO, 4, 1.0f / DM, EPS, 1.0f}, F.lds + LDS_X_OFF, EPI_DBG1, x, (float*)(ws + WS_ACT)};
      pg8::gemm_phase<pg8::EpiResNorm<true>, pg8::StaticOrder, true, true>(F.lds, g, S, E, F.wave); }
    }
    xcd_barrier(bar); STAMP();
    for (int rep_ = 0; rep_ < REP5; ++rep_) { if (rep_) xcd_barrier(bar);
    { pg8::Gemm g{H, (const bf16*)(ws + WS_WIN), M, DIN, DM}; pg8::StaticOrder S; S.init(M, DIN, F.G, (int)blockIdx.x);
      pg8::EpiWin E{(bf16*)(ws + WS_Q), (bf16*)(ws + WS_K), (bf16*)(ws + WS_V), (bf16*)(ws + WS_AS)}; pg8::gemm_phase<pg8::EpiWin, pg8::StaticOrder, true, true>(F.lds, g, S, E, F.wave); }
    p0_weights<1>(F, args);
    }
    xcd_barrier(bar); STAMP();
    for (int rep_ = 0; rep_ < REP6; ++rep_) { if (rep_) xcd_barrier(bar);
    ssm_state_scan(F, args);
    attn_phase(F, args);
#ifdef FUSE_Y
    if ((int)blockIdx.x < 256) { asm volatile("s_waitcnt vmcnt(0)" ::: "memory"); __syncthreads();
      pg8::Gemm g{(const bf16*)(ws + WS_AS), (const bf16*)(ws + WS_TW), NGRP * 2048, NGRP * 256, KSS}; pg8::OneUnit S{(int)blockIdx.x, (int)blockIdx.x >> 3};
      pg8::EpiSsmY E{(bf16*)(ws + WS_YG)}; pg8::gemm_phase<pg8::EpiSsmY, pg8::OneUnit, true, true>(F.lds, g, S, E, F.wave); }
#endif
    }
    xcd_barrier(bar); STAMP();
#ifndef FUSE_Y
    for (int rep_ = 0; rep_ < REP8; ++rep_) { if (rep_) xcd_barrier(bar);
    { pg8::Gemm g{(const bf16*)(ws + WS_AS), (const bf16*)(ws + WS_TW), NGRP * 2048, NGRP * 256, KSS}; pg8::SsmOrder S{F.G, (int)blockIdx.x};
      pg8::EpiSsmY E{(bf16*)(ws + WS_YG)}; pg8::gemm_phase<pg8::EpiSsmY, pg8::SsmOrder, true, true>(F.lds, g, S, E, F.wave); }
    }
    xcd_barrier(bar); STAMP();
#endif
    for (int rep_ = 0; rep_ < REP9; ++rep_) { if (rep_) xcd_barrier(bar);
    { pg8::Gemm g{(const bf16*)(ws + WS_YG), (const bf16*)(ws + WS_WGLU), M, DSSM, DSSM}; pg8::StaticOrder S; S.init(M, DSSM, F.G, (int)blockIdx.x);
      pg8::EpiGluNorm E{(const bf16*)(ws + WS_YG), H, args.in[I_BGLU], args.in[I_GSSM], pg8::RowStats{(unsigned long long*)(ws + WS_XB) + 5 * (size_t)M, ctl + CW_TMO, 2, 1.0f / DSSM, EPS, 1.0f}, F.lds + LDS_X_OFF};
      pg8::gemm_phase<pg8::EpiGluNorm, pg8::StaticOrder, true, true>(F.lds, g, S, E, F.wave); }
    }
    xcd_barrier(bar); STAMP();
    for (int rep_ = 0; rep_ < REP11; ++rep_) { if (rep_) xcd_barrier(bar);
    { pg8::Gemm g{H, (const bf16*)(ws + WS_WOUT), M, DM, DM}; pg8::StaticOrder S; S.init(M, DM, F.G, (int)blockIdx.x);
      pg8::EpiResNorm<true> E{out, out, H, mod + 5 * DM, args.in[I_GPOSTM], args.in[I_GPRE2], mod + 6 * DM, mod + 7 * DM, NMOD, pg8::RowStats{(unsigned long long*)(ws + WS_XB) + 2 * (size_t)M, ctl + CW_TMO, 4, 1.0f / DM, EPS, 1.0f}, pg8::RowStats{(unsigned long long*)(ws + WS_XB) + 3 * (size_t)M, ctl + CW_TMO, 4, 1.0f / DM, EPS, 1.0f}, F.lds + LDS_X_OFF, EPI_DBG2, x, (float*)(ws + WS_ACT)};
      pg8::gemm_phase<pg8::EpiResNorm<true>, pg8::StaticOrder, true, true>(F.lds, g, S, E, F.wave); }
    }
    xcd_barrier(bar); STAMP();
    for (int rep_ = 0; rep_ < REP14; ++rep_) { if (rep_) xcd_barrier(bar);
    { pg8::Gemm g{H, (const bf16*)(ws + WS_W2GU), M, 2 * DFF, DM}; pg8::StaticOrder S; S.init(M, 2 * DFF, F.G, (int)blockIdx.x, GU_WGM);
      pg8::EpiSwiGLU E{ACT, DFF, DOWN_BLK}; pg8::gemm_phase<pg8::EpiSwiGLU, pg8::StaticOrder, GU_ALIGN, GU_SP2>(F.lds, g, S, E, F.wave); }
    }
    xcd_barrier(bar); STAMP();
    for (int rep_ = 0; rep_ < REP15; ++rep_) { if (rep_) xcd_barrier(bar);
    { pg8::Gemm g{ACT, (const bf16*)(ws + WS_W2D), M, DM, DFF, DOWN_BLK, DOWN_BLK}; pg8::StaticOrder S; S.init(M, DM, F.G, (int)blockIdx.x, 8, DOWN_REV);
      pg8::EpiResNorm<false> E{out, out, H, mod + 8 * DM, args.in[I_GPOST2], args.in[I_GPOST2], mod + 8 * DM, mod + 8 * DM, NMOD, pg8::RowStats{(unsigned long long*)(ws + WS_XB) + 4 * (size_t)M, ctl + CW_TMO, 4, 1.0f / DM, EPS, 0.5f}, pg8::RowStats{(unsigned long long*)(ws + WS_XB) + 4 * (size_t)M, ctl + CW_TMO, 4, 1.0f / DM, EPS, 1.0f}, F.lds + LDS_X_OFF, EPI_DBG3, x, (float*)(ws + WS_ACT)};
      pg8::gemm_phase<pg8::EpiResNorm<false>, pg8::StaticOrder, true, true>(F.lds, g, S, E, F.wave); }
    }
    for (int xs_ = 0; xs_ < XSYNC; ++xs_) xcd_barrier(bar);
#ifdef STAMP_A
    xcd_barrier(bar); STAMP();
#ifdef STAMP_CLK
    if (blockIdx.x == 0 && F.tid == 0) out[0] += (float)(tsl[16 + STAMP_B] - tsl[16 + STAMP_A]) / (float)(tsl[STAMP_B] - tsl[STAMP_A]) * STAMP_SCALE;
#else
    if (blockIdx.x == 0 && F.tid == 0) out[0] += (float)(tsl[STAMP_B] - tsl[STAMP_A]) * STAMP_SCALE;
#endif
#endif
}

extern "C" void kernel_launch(void* const* d_in, const int* in_sizes, int n_in, void* d_out, int out_size, void* d_ws, size_t ws_size, hipStream_t stream) {
    static int grid = 0;
    if (grid == 0) {
        if (n_in != 31 || in_sizes[0] != M * DM || out_size != M * DM || ws_size < WS_END) {
            fprintf(stderr, "kernel_launch: unexpected shapes (n_in %d, in0 %d, out %d, ws %zu, need %zu); nothing launched\n", n_in, n_in > 0 ? in_sizes[0] : -1, out_size, ws_size, (size_t)WS_END); grid = -1; return; }
        int dev = 0, cus = 0, per_cu = 0;
        if (hipGetDevice(&dev) != hipSuccess || hipDeviceGetAttribute(&cus, hipDeviceAttributeMultiprocessorCount, dev) != hipSuccess) { fprintf(stderr, "kernel_launch: device query failed\n"); grid = -1; return; }
        if (hipFuncSetAttribute((const void*)fwd_megakernel, hipFuncAttributeMaxDynamicSharedMemorySize, LDS_BYTES) != hipSuccess) { fprintf(stderr, "kernel_launch: hipFuncSetAttribute failed\n"); grid = -1; return; }
        if (hipOccupancyMaxActiveBlocksPerMultiprocessor(&per_cu, (const void*)fwd_megakernel, NTHR, LDS_BYTES) != hipSuccess || per_cu < 1) { fprintf(stderr, "kernel_launch: occupancy query says %d blocks per CU\n", per_cu); per_cu = 1; }
        (void)hipGetLastError();
        grid = cus < 256 ? cus : 256;
        fprintf(stderr, "kernel_launch: %d CUs, occupancy %d/CU, grid %d\n", cus, per_cu, grid);
    }
    if (grid < 0) return;
    if (hipMemsetAsync((char*)d_ws + WS_CTL, 0, CTL_ZERO_BYTES, stream) != hipSuccess) { fprintf(stderr, "kernel_launch: hipMemsetAsync failed\n"); return; }
    Args a{};
    for (int i = 0; i < 31; ++i) a.in[i] = (const float*)d_in[i];
    a.out = (float*)d_out; a.ws = (unsigned char*)d_ws;
    hipLaunchKernelGGL(fwd_megakernel, dim3(grid), dim3(NTHR), LDS_BYTES, stream, a);
    const hipError_t le = hipPeekAtLastError();
    if (le != hipSuccess) fprintf(stderr, "kernel_launch: launch failed: %s (grid %d)\n", hipGetErrorName(le), grid);
}
```

```cpp
#include <hip/hip_runtime.h>
#include <cstdio>
#include <cstdint>
namespace pg8 {
#define PG8_LAS __attribute__((address_space(3)))
typedef unsigned short bf16_t;
typedef short bf16x8 __attribute__((ext_vector_type(8)));
typedef float f32x4 __attribute__((ext_vector_type(4)));
typedef unsigned u32x4 __attribute__((ext_vector_type(4)));
constexpr int BM = 256, BK = 64, HALF = 128, HTB = HALF * BK * 2  , STAGE_BYTES = 8 * HTB, NXCD = 8, WGM = 8;

__host__ __device__ __forceinline__ int lds_byte(int r, int c) { const int st = (r >> 4) * 2 + (c >> 5), rr = r & 15, cc = c & 31, ob = rr * 64 + cc * 2; return st * 1024 + (ob ^ (((ob >> 9) & 1) << 5)); }
__host__ __device__ __forceinline__ void stage_rc(int b, int& R, int& C) { const int st = b / 1024, sb = b % 1024, swz = sb ^ (((sb >> 9) & 1) << 5); R = (st >> 1) * 16 + swz / 64; C = (st & 1) * 32 + (swz % 64) / 2; }
__host__ __device__ __forceinline__ int perm32(int rho) { const int n = rho >> 4, i = rho & 15; return 8 * (i >> 2) + 4 * n + (i & 3); }

struct Unit { int pm, pn; };
struct Gemm { const bf16_t* A; const bf16_t* Bt; int M, N, K; int blkA = 0, blkB = 0; };

struct StaticOrder {
    int nM, nN, nwg, G, c, wgm, rev;
    __host__ __device__ void init(int M, int N, int G_, int c_, int wgm_ = WGM, int rev_ = 0) { nM = M / BM; nN = N / BM; nwg = nM * nN; G = G_; c = c_; wgm = wgm_; rev = rev_; }
    __host__ __device__ bool next(int i, Unit& u) const {
        if ((long)i * G + c >= nwg) return false;
        const long L = (long)(rev ? (nwg / G - 1 - i) : i) * G + c;
        int wgid = (int)L; { const int q = nwg / NXCD, r = nwg % NXCD, xcd = wgid % NXCD, off = wgid / NXCD; wgid = (xcd < r ? xcd * (q + 1) : r * (q + 1) + (xcd - r) * q) + off; }
        const int nig = wgm * nN, gid = wgid / nig, fm = gid * wgm, gsz = (nM - fm) < wgm ? (nM - fm) : wgm;
        u.pm = fm + ((wgid % nig) % gsz); u.pn = (wgid % nig) / gsz; return true;
    }
    __device__ __forceinline__ void a_ready(const Unit&) const {}
    __device__ __forceinline__ void done(const Unit&) const {}
};

__device__ __forceinline__ unsigned cvt_pk_bf16(float lo, float hi) { unsigned r; asm volatile("v_cvt_pk_bf16_f32 %0, %1, %2" : "=v"(r) : "v"(lo), "v"(hi)); return r; }
typedef float f32x2 __attribute__((ext_vector_type(2)));
__device__ __forceinline__ f32x2 gelu_pk(f32x2 v) {
    const f32x2 av = __builtin_elementwise_abs(v), d = av * 0.2316418882f + 1.0f;
    f32x2 t; t.x = __builtin_amdgcn_rcpf(d.x); t.y = __builtin_amdgcn_rcpf(d.y);
    f32x2 q = t * 0.5307027145f + (-0.7265760135f); q = q * t + 0.7107068705f; q = q * t + (-0.142248368f); q = q * t + 0.127414796f; q = q * t;
    const f32x2 s = (v * v) * (-0.72134752044f);
    f32x2 e; e.x = __builtin_amdgcn_exp2f(s.x); e.y = __builtin_amdgcn_exp2f(s.y);
    const f32x2 m = v * (q * e), r = v - m;
    f32x2 o; o.x = v.x < 0.f ? m.x : r.x; o.y = v.y < 0.f ? m.y : r.y; return o;
}

template <int ACT  > struct EpiBf16 {
    static constexpr bool PERM = true, AFTER_DRAIN = false; static_assert(ACT == 0 || ACT == 1, "EpiBf16: ACT is 0 (none) or 1 (gelu_pk)");
    bf16_t* O; int ldc; const float* bias; int split_cols; size_t split_stride; float scale0;
    __device__ __forceinline__ void operator()(const f32x4 (&acc)[2][2][4][2], const Unit& u, int wr, int wc, int fr, int fq) const {
        const int row0 = u.pm * BM + wr * 64 + fr; int colt = u.pn * BM; bf16_t* base = O;
        float sc = 1.f; if (split_cols) { const int t = colt / split_cols; base += (size_t)t * split_stride; colt -= t * split_cols; if (t == 0) sc = scale0; }
        const int col0 = colt + wc * 32 + 8 * fq, bcol0 = u.pn * BM + wc * 32 + 8 * fq;
        f32x4 bv[2][2];
#pragma unroll
        for (int bj = 0; bj < 2; ++bj)
#pragma unroll
            for (int n = 0; n < 2; ++n) bv[bj][n] = bias ? *(const f32x4*)(bias + bcol0 + bj * HALF + 4 * n) : (f32x4){0.f, 0.f, 0.f, 0.f};
#pragma unroll
        for (int ai = 0; ai < 2; ++ai)
#pragma unroll
            for (int m = 0; m < 4; ++m) { bf16_t* rowp = base + (size_t)(row0 + ai * HALF + m * 16) * ldc + col0;
#pragma unroll
                for (int bj = 0; bj < 2; ++bj) { f32x4 v0 = acc[ai][bj][m][0] + bv[bj][0], v1 = acc[ai][bj][m][1] + bv[bj][1];
                    if (ACT == 1) { f32x2 a = gelu_pk((f32x2){v0[0], v0[1]}), b = gelu_pk((f32x2){v0[2], v0[3]}), c = gelu_pk((f32x2){v1[0], v1[1]}), d = gelu_pk((f32x2){v1[2], v1[3]});
                        v0 = (f32x4){a.x, a.y, b.x, b.y}; v1 = (f32x4){c.x, c.y, d.x, d.y}; }
                    v0 = v0 * sc; v1 = v1 * sc; u32x4 w; w.x = cvt_pk_bf16(v0[0], v0[1]); w.y = cvt_pk_bf16(v0[2], v0[3]); w.z = cvt_pk_bf16(v1[0], v1[1]); w.w = cvt_pk_bf16(v1[2], v1[3]);
                    *(u32x4*)(rowp + bj * HALF) = w; } }
    }
};

struct PanelStats {
    unsigned* xbuf;
    unsigned* cnt;
    unsigned* tmo;
    int ntn; float eps;
    unsigned code;
    __device__ __forceinline__ bool run(const f32x4 (&v)[2][2][4][2], const Unit& u, int wr, int wc, int fr, int fq, PG8_LAS unsigned char* lds, int wid, int lane) const {
        typedef float f32x2v __attribute__((ext_vector_type(2)));
        PG8_LAS f32x2v* P = (PG8_LAS f32x2v*)lds;
        PG8_LAS f32x2v* S = (PG8_LAS f32x2v*)(lds + 8192);
        PG8_LAS unsigned* flag = (PG8_LAS unsigned*)(lds + 8192 + 2048);
#pragma unroll
        for (int ai = 0; ai < 2; ++ai)
#pragma unroll
            for (int m = 0; m < 4; ++m) {
                float s = 0.f;
#pragma unroll
                for (int bj = 0; bj < 2; ++bj)
#pragma unroll
                    for (int n = 0; n < 2; ++n) { const f32x4 x = v[ai][bj][m][n]; s += (x[0] + x[1]) + (x[2] + x[3]); }
                s += __shfl_xor(s, 16); s += __shfl_xor(s, 32);
                const float mw = s * (1.0f / 64.0f); float q = 0.f;
#pragma unroll
                for (int bj = 0; bj < 2; ++bj)
#pragma unroll
                    for (int n = 0; n < 2; ++n) { const f32x4 d = v[ai][bj][m][n] - mw; q += (d[0] * d[0] + d[1] * d[1]) + (d[2] * d[2] + d[3] * d[3]); }
                q += __shfl_xor(q, 16); q += __shfl_xor(q, 32);
                if (fq == 0) P[(ai * HALF + wr * 64 + m * 16 + fr) * 4 + wc] = (f32x2v){mw, q};
            }
        asm volatile("s_waitcnt lgkmcnt(0)" ::: "memory"); __builtin_amdgcn_s_barrier(); asm volatile("" ::: "memory");
#if defined(BROKEN_EXCHANGE_NO_WAIT)
#warning BROKEN CONTROL BUILD: the row-statistics exchange does not wait; results are wrong by design
        if (blockIdx.x >= 64) { const long long t0_ = clock64(); while (clock64() - t0_ < 60000) __builtin_amdgcn_s_sleep(8); }
#endif
        const int row = wid * 32 + (lane & 31);
        if (lane < 32) {
            const f32x2v a = P[row * 4 + 0], b = P[row * 4 + 1], c = P[row * 4 + 2], d = P[row * 4 + 3];
            const float mt = (a.x + b.x + c.x + d.x) * 0.25f;
            const float da = a.x - mt, db = b.x - mt, dc = c.x - mt, dd = d.x - mt;
            const float m2 = (a.y + b.y) + (c.y + d.y) + 64.0f * ((da * da + db * db) + (dc * dc + dd * dd));
            unsigned long long* slot = (unsigned long long*)xbuf + ((size_t)(u.pm * BM + row) * 4 + u.pn);
            __hip_atomic_store(slot, ((unsigned long long)__float_as_uint(m2) << 32) | __float_as_uint(mt), __ATOMIC_RELAXED, __HIP_MEMORY_SCOPE_AGENT);
        }
        asm volatile("s_waitcnt vmcnt(0)" ::: "memory");
        if (lane == 0) __hip_atomic_fetch_add(cnt + 64 * u.pm, 1u, __ATOMIC_RELAXED, __HIP_MEMORY_SCOPE_AGENT);
        if (wid == 0) {
            bool dead = false; const unsigned long long t0 = __builtin_amdgcn_s_memrealtime(); const unsigned want = 8u * (unsigned)ntn;
            for (;;) {
#if defined(BROKEN_EXCHANGE_NO_WAIT)
                break;
#endif
                if ((unsigned)__builtin_amdgcn_readfirstlane(__hip_atomic_load(cnt + 64 * u.pm, __ATOMIC_RELAXED, __HIP_MEMORY_SCOPE_AGENT)) >= want) break;
                if (__builtin_amdgcn_s_memrealtime() - t0 > 2000000ull) {
                    if (lane == 0) { unsigned expect = 0u; __hip_atomic_compare_exchange_strong(tmo + 1, &expect, code | (unsigned)(u.pm & 0xff), __ATOMIC_RELAXED, __ATOMIC_RELAXED, __HIP_MEMORY_SCOPE_AGENT);
                                     __hip_atomic_store(tmo, 1u, __ATOMIC_RELAXED, __HIP_MEMORY_SCOPE_AGENT); }
                    dead = true; break; }
                __builtin_amdgcn_s_sleep(2);
            }
            __builtin_amdgcn_fence(__ATOMIC_ACQUIRE, "agent");
            if (lane == 0) flag[0] = dead ? 1u : 0u;
        }
        asm volatile("s_waitcnt vmcnt(0) lgkmcnt(0)" ::: "memory"); __builtin_amdgcn_s_barrier(); asm volatile("" ::: "memory");
        const bool bad = flag[0] != 0u;
        if (lane < 32) {
            const unsigned long long* slot = (const unsigned long long*)xbuf + (size_t)(u.pm * BM + row) * 4; float mt[4], m2[4]; float ms = 0.f;
#pragma unroll
            for (int t = 0; t < 4; ++t) { if (t < ntn) { const unsigned long long w = __hip_atomic_load(slot + t, __ATOMIC_RELAXED, __HIP_MEMORY_SCOPE_AGENT); mt[t] = __uint_as_float((unsigned)w); m2[t] = __uint_as_float((unsigned)(w >> 32)); } else { mt[t] = 0.f; m2[t] = 0.f; } ms += mt[t]; }
            const float mean = ms / (float)ntn; float q = 0.f;
#pragma unroll
            for (int t = 0; t < 4; ++t) if (t < ntn) { const float dm = mt[t] - mean; q += m2[t] + 256.0f * dm * dm; }
            S[row] = (f32x2v){mean, 1.0f / sqrtf(q / (256.0f * (float)ntn) + eps)};
        }
        asm volatile("s_waitcnt lgkmcnt(0)" ::: "memory"); __builtin_amdgcn_s_barrier(); asm volatile("" ::: "memory");
        return bad;
    }
};
struct EpiLnRes {
    static constexpr bool PERM = false, AFTER_DRAIN = true;
    const float* base; float* out; int ldc; const float* bias; PanelStats st; unsigned poison;
    __device__ __forceinline__ void fused(f32x4 (&acc)[2][2][4][2], const Unit& u, int wr, int wc, int fr, int fq, PG8_LAS unsigned char* lds, int wid, int lane) const {
        typedef float f32x2v __attribute__((ext_vector_type(2)));
        const PG8_LAS f32x2v* S = (const PG8_LAS f32x2v*)(lds + 8192);
        const int col0 = u.pn * BM + wc * 32 + 4 * fq;
#pragma unroll
        for (int bj = 0; bj < 2; ++bj)
#pragma unroll
            for (int n = 0; n < 2; ++n) { const f32x4 bv = bias ? *(const f32x4*)(bias + col0 + bj * HALF + n * 16) : (f32x4){0.f, 0.f, 0.f, 0.f};
#pragma unroll
                for (int ai = 0; ai < 2; ++ai)
#pragma unroll
                    for (int m = 0; m < 4; ++m) acc[ai][bj][m][n] += bv; }
        f32x4 pre[4][2][2];
#pragma unroll
        for (int m = 0; m < 4; ++m) { const size_t off = (size_t)(u.pm * BM + wr * 64 + m * 16 + fr) * ldc + col0;
#pragma unroll
            for (int bj = 0; bj < 2; ++bj)
#pragma unroll
                for (int n = 0; n < 2; ++n) pre[m][bj][n] = *(const f32x4*)(base + off + bj * HALF + n * 16); }
        const bool bad = st.run(acc, u, wr, wc, fr, fq, lds, wid, lane) || poison != 0u;
        const float qnan = __builtin_nanf("");
#pragma unroll
        for (int ai = 0; ai < 2; ++ai)
#pragma unroll
            for (int m = 0; m < 4; ++m) { const int r = ai * HALF + wr * 64 + m * 16 + fr; const f32x2v sr = S[r]; const size_t off = (size_t)(u.pm * BM + r) * ldc + col0;
#pragma unroll
                for (int bj = 0; bj < 2; ++bj)
#pragma unroll
                    for (int n = 0; n < 2; ++n) { const f32x4 bs = ai == 0 ? pre[m][bj][n] : *(const f32x4*)(base + off + bj * HALF + n * 16); f32x4 o = bs + (acc[ai][bj][m][n] - sr.x) * sr.y;
                        if (bad) o = (f32x4){qnan, qnan, qnan, qnan}; *(f32x4*)(out + off + bj * HALF + n * 16) = o; }
                if (m & 1) asm volatile("" ::: "memory"); }
    }
};
struct EpiLnResLn {
    static constexpr bool PERM = false, AFTER_DRAIN = true;
    const float* base; float* out; bf16_t* xn; int ldc; const float* bias; PanelStats st1, st2; unsigned poison;
    __device__ __forceinline__ void fused(f32x4 (&acc)[2][2][4][2], const Unit& u, int wr, int wc, int fr, int fq, PG8_LAS unsigned char* lds, int wid, int lane) const {
        typedef float f32x2v __attribute__((ext_vector_type(2))); typedef unsigned u32x2v __attribute__((ext_vector_type(2)));
        const PG8_LAS f32x2v* S = (const PG8_LAS f32x2v*)(lds + 8192);
        const int col0 = u.pn * BM + wc * 32 + 4 * fq;
#pragma unroll
        for (int bj = 0; bj < 2; ++bj)
#pragma unroll
            for (int n = 0; n < 2; ++n) { const f32x4 bv = bias ? *(const f32x4*)(bias + col0 + bj * HALF + n * 16) : (f32x4){0.f, 0.f, 0.f, 0.f};
#pragma unroll
                for (int ai = 0; ai < 2; ++ai)
#pragma unroll
                    for (int m = 0; m < 4; ++m) acc[ai][bj][m][n] += bv; }
        bool bad = st1.run(acc, u, wr, wc, fr, fq, lds, wid, lane) || poison != 0u;
        const float qnan = __builtin_nanf("");
#pragma unroll
        for (int ai = 0; ai < 2; ++ai)
#pragma unroll
            for (int m = 0; m < 4; ++m) { const int r = ai * HALF + wr * 64 + m * 16 + fr; const f32x2v sr = S[r]; const size_t off = (size_t)(u.pm * BM + r) * ldc + col0;
#pragma unroll
                for (int bj = 0; bj < 2; ++bj)
#pragma unroll
                    for (int n = 0; n < 2; ++n) { const f32x4 bs = *(const f32x4*)(base + off + bj * HALF + n * 16); acc[ai][bj][m][n] = bs + (acc[ai][bj][m][n] - sr.x) * sr.y; }
                asm volatile("" : "+v"(acc[ai][0][m][0]), "+v"(acc[ai][0][m][1]), "+v"(acc[ai][1][m][0]), "+v"(acc[ai][1][m][1]));
                if (m & 1) asm volatile("" ::: "memory"); }
        const bool bad1 = bad;
        bad = st2.run(acc, u, wr, wc, fr, fq, lds, wid, lane) || bad;
#pragma unroll
        for (int ai = 0; ai < 2; ++ai)
#pragma unroll
            for (int m = 0; m < 4; ++m) { const int r = ai * HALF + wr * 64 + m * 16 + fr; const f32x2v sr = S[r]; const size_t off = (size_t)(u.pm * BM + r) * ldc + col0;
#pragma unroll
                for (int bj = 0; bj < 2; ++bj)
#pragma unroll
                    for (int n = 0; n < 2; ++n) { const f32x4 x1 = acc[ai][bj][m][n]; *(f32x4*)(out + off + bj * HALF + n * 16) = bad1 ? (f32x4){qnan, qnan, qnan, qnan} : x1;
                        const f32x4 o = (x1 - sr.x) * sr.y; u32x2v w; w.x = cvt_pk_bf16(o[0], o[1]); w.y = cvt_pk_bf16(o[2], o[3]);
                        if (bad) { w.x = 0x7fc07fc0u; w.y = 0x7fc07fc0u; } *(u32x2v*)(xn + off + bj * HALF + n * 16) = w; }
                asm volatile("" ::: "memory"); }
    }
};

template <class Epi, class Sched, bool ALIGN_EPI = false, bool SP2 = false>
__device__ __forceinline__ void gemm_phase(PG8_LAS unsigned char* lds, const Gemm g, const Sched& S, const Epi& E, const int wave_s) {
    int tid_ = wave_s * 64 + (int)__builtin_amdgcn_mbcnt_hi(~0u, __builtin_amdgcn_mbcnt_lo(~0u, 0u)); asm volatile("" : "+v"(tid_));
    const int tid = tid_, wid = __builtin_amdgcn_readfirstlane(tid >> 6), lane = tid & 63, wr = wid >> 2, wc = wid & 3, fr = lane & 15, fq = lane >> 4;
    const int K = g.K, nt = K / BK;
    unsigned voffA[2], voffB[2];
#pragma unroll
    for (int i = 0; i < 2; ++i) { int R, C; stage_rc(tid * 16 + i * 8192, R, C); const int Rb = Epi::PERM ? ((R & ~31) + perm32(R & 31)) : R;
        voffA[i] = (unsigned)(R * (g.blkA ? BK : K) + C) * 2u; voffB[i] = (unsigned)(Rb * (g.blkB ? BK : K) + C) * 2u; }
    const size_t kstepA = g.blkA ? (size_t)BM * BK * 2 : (size_t)(BK * 2), kstepB = g.blkB ? (size_t)BM * BK * 2 : (size_t)(BK * 2);
    const size_t hstepA = g.blkA ? (size_t)HALF * BK * 2 : (size_t)HALF * K * 2, hstepB = g.blkB ? (size_t)HALF * BK * 2 : (size_t)HALF * K * 2;
    const size_t tstepA = (size_t)BM * K * 2, tstepB = tstepA;
    const unsigned ldsw = (unsigned)wid * 1024u;
    const int aoff = lds_byte(wr * 64 + fr, fq * 8), boff = lds_byte(wc * 32 + fr, fq * 8);
#define PG8_SA(b, h) (((b) * 2 + (h)) * HTB)
#define PG8_SB(b, h) ((4 + (b) * 2 + (h)) * HTB)
#define PG8_STAGE(bufoff, gbase, voff) do { _Pragma("unroll") for (int _i = 0; _i < 2; ++_i) \
        __builtin_amdgcn_global_load_lds((const unsigned*)((const char*)(gbase) + (voff)[_i]), (PG8_LAS unsigned*)(lds + (bufoff) + ldsw + _i * 8192), 16, 0, 0); } while (0)
#define PG8_LDA(dst, b, h) do { _Pragma("unroll") for (int m = 0; m < 4; ++m) _Pragma("unroll") for (int k = 0; k < 2; ++k) dst[m][k] = *(const PG8_LAS bf16x8*)(lds + PG8_SA(b, h) + aoff + m * 2048 + k * 1024); } while (0)
#define PG8_LDB(dst, b, h) do { _Pragma("unroll") for (int n = 0; n < 2; ++n) _Pragma("unroll") for (int k = 0; k < 2; ++k) dst[n][k] = *(const PG8_LAS bf16x8*)(lds + PG8_SB(b, h) + boff + n * 2048 + k * 1024); } while (0)
#define PG8_MMA(ai, bj, At, Bt) do { __builtin_amdgcn_s_setprio(1); _Pragma("unroll") for (int m = 0; m < 4; ++m) _Pragma("unroll") for (int n = 0; n < 2; ++n) _Pragma("unroll") for (int k = 0; k < 2; ++k) \
        acc[ai][bj][m][n] = __builtin_amdgcn_mfma_f32_16x16x32_bf16(Bt[n][k], At[m][k], acc[ai][bj][m][n], 0, 0, 0); __builtin_amdgcn_s_setprio(0); } while (0)
#define PG8_WAIT_V(n) asm volatile("s_waitcnt vmcnt(" #n ")" ::: "memory")
#define PG8_WAIT_L(n) asm volatile("s_waitcnt lgkmcnt(" #n ")" ::: "memory")
#define PG8_BAR __builtin_amdgcn_s_barrier()
#define PG8_SCHED __builtin_amdgcn_sched_barrier(0)
    Unit cur, nxt; int ui = 0;
    if (!S.next(0, cur)) return;
    f32x4 acc[2][2][4][2];
#pragma unroll
    for (int a = 0; a < 2; ++a)
#pragma unroll
        for (int b = 0; b < 2; ++b)
#pragma unroll
            for (int m = 0; m < 4; ++m)
#pragma unroll
                for (int n = 0; n < 2; ++n) acc[a][b][m][n] = (f32x4){0.f, 0.f, 0.f, 0.f};
    bf16x8 At[4][2], B0[2][2], B1[2][2];
    const char* cA = (const char*)g.A + (size_t)cur.pm * tstepA; const char* cB = (const char*)g.Bt + (size_t)cur.pn * tstepB;
    S.a_ready(cur);
    if constexpr (SP2) {
        PG8_STAGE(PG8_SB(0, 0), cB, voffB); PG8_STAGE(PG8_SB(0, 1), cB + hstepB, voffB); PG8_STAGE(PG8_SA(0, 0), cA, voffA); PG8_STAGE(PG8_SA(0, 1), cA + hstepA, voffA);
        if (wr == 1) PG8_BAR;
        PG8_WAIT_V(2); PG8_BAR;
        PG8_STAGE(PG8_SB(1, 0), cB + kstepB, voffB); PG8_STAGE(PG8_SA(1, 0), cA + kstepA, voffA); PG8_STAGE(PG8_SB(1, 1), cB + hstepB + kstepB, voffB);
        PG8_WAIT_V(6); PG8_BAR;
    } else {
        PG8_STAGE(PG8_SB(0, 0), cB, voffB); PG8_STAGE(PG8_SA(0, 0), cA, voffA); PG8_STAGE(PG8_SB(0, 1), cB + hstepB, voffB); PG8_STAGE(PG8_SA(0, 1), cA + hstepA, voffA);
        if (wr == 1) PG8_BAR;
        PG8_WAIT_V(4); PG8_BAR;
        PG8_STAGE(PG8_SB(1, 0), cB + kstepB, voffB); PG8_STAGE(PG8_SA(1, 0), cA + kstepA, voffA); PG8_STAGE(PG8_SB(1, 1), cB + hstepB + kstepB, voffB);
        PG8_WAIT_V(6); PG8_BAR;
    }
    for (;;) {
        const bool has_next = S.next(ui + 1, nxt);
        const char* nA = has_next ? (const char*)g.A + (size_t)nxt.pm * tstepA : cA; const char* nB = has_next ? (const char*)g.Bt + (size_t)nxt.pn * tstepB : cB;
#pragma unroll 1
        for (int t = 0; t < nt; t += 2) {
            const bool last = (t == nt - 2);
            const char* a1 = cA + (size_t)(t + 1) * kstepA;
            const char* a2 = last ? nA : cA + (size_t)(t + 2) * kstepA; const char* b2 = last ? nB : cB + (size_t)(t + 2) * kstepB;
            const char* a3 = a2 + kstepA; const char* b3 = b2 + kstepB;
            if (last && has_next) S.a_ready(nxt);
            if constexpr (SP2) {
            PG8_LDB(B0, 0, 0); PG8_LDB(B1, 0, 1); PG8_SCHED; PG8_LDA(At, 0, 0); PG8_STAGE(PG8_SA(1, 1), a1 + hstepA, voffA);
            PG8_WAIT_V(8); PG8_WAIT_L(0); PG8_BAR; PG8_MMA(0, 0, At, B0); PG8_MMA(0, 1, At, B1); PG8_BAR; PG8_SCHED;
            PG8_LDA(At, 0, 1); PG8_STAGE(PG8_SB(0, 0), b2, voffB); PG8_STAGE(PG8_SB(0, 1), b2 + hstepB, voffB); PG8_STAGE(PG8_SA(0, 0), a2, voffA);
            PG8_WAIT_V(8); PG8_WAIT_L(0); PG8_BAR; PG8_MMA(1, 0, At, B0); PG8_MMA(1, 1, At, B1); PG8_BAR; PG8_SCHED;
            PG8_LDB(B0, 1, 0); PG8_LDB(B1, 1, 1); PG8_SCHED; PG8_LDA(At, 1, 0); PG8_STAGE(PG8_SA(0, 1), a2 + hstepA, voffA);
            PG8_WAIT_V(8); PG8_WAIT_L(0); PG8_BAR; PG8_MMA(0, 0, At, B0); PG8_MMA(0, 1, At, B1); PG8_BAR; PG8_SCHED;
            PG8_LDA(At, 1, 1); PG8_STAGE(PG8_SB(1, 0), b3, voffB); PG8_STAGE(PG8_SB(1, 1), b3 + hstepB, voffB); PG8_STAGE(PG8_SA(1, 0), a3, voffA);
            PG8_WAIT_V(8); PG8_WAIT_L(0); PG8_BAR; PG8_MMA(1, 0, At, B0); PG8_MMA(1, 1, At, B1); PG8_BAR; PG8_SCHED;
            } else {
            PG8_LDB(B0, 0, 0); PG8_SCHED; PG8_LDA(At, 0, 0); PG8_STAGE(PG8_SA(1, 1), a1 + hstepA, voffA);
            PG8_WAIT_L(8); PG8_BAR; PG8_WAIT_L(0); PG8_MMA(0, 0, At, B0); PG8_BAR; PG8_SCHED;
            PG8_LDB(B1, 0, 1); PG8_STAGE(PG8_SB(0, 0), b2, voffB);
            PG8_BAR; PG8_WAIT_L(0); PG8_MMA(0, 1, At, B1); PG8_BAR;
            PG8_LDA(At, 0, 1); PG8_STAGE(PG8_SA(0, 0), a2, voffA);
            PG8_BAR; PG8_WAIT_L(0); PG8_MMA(1, 0, At, B0); PG8_BAR; PG8_SCHED;
            PG8_STAGE(PG8_SB(0, 1), b2 + hstepB, voffB);
            PG8_WAIT_V(6); PG8_BAR; PG8_MMA(1, 1, At, B1); PG8_BAR;
            PG8_LDB(B0, 1, 0); PG8_SCHED; PG8_LDA(At, 1, 0); PG8_STAGE(PG8_SA(0, 1), a2 + hstepA, voffA);
            PG8_WAIT_L(8); PG8_BAR; PG8_WAIT_L(0); PG8_MMA(0, 0, At, B0); PG8_BAR; PG8_SCHED;
            PG8_LDB(B1, 1, 1); PG8_STAGE(PG8_SB(1, 0), b3, voffB);
            PG8_BAR; PG8_WAIT_L(0); PG8_MMA(0, 1, At, B1); PG8_BAR;
            PG8_LDA(At, 1, 1); PG8_STAGE(PG8_SA(1, 0), a3, voffA);
            PG8_BAR; PG8_WAIT_L(0); PG8_MMA(1, 0, At, B0); PG8_BAR; PG8_SCHED;
            PG8_STAGE(PG8_SB(1, 1), b3 + hstepB, voffB);
            PG8_WAIT_V(6); PG8_BAR; PG8_MMA(1, 1, At, B1); PG8_BAR;
            }
        }
        if constexpr (ALIGN_EPI) { if (wr == 0) PG8_BAR; }
        if constexpr (!Epi::AFTER_DRAIN) { E(acc, cur, wr, wc, fr, fq); S.done(cur); }
        if (!has_next) break;
#pragma unroll
        for (int a = 0; a < 2; ++a)
#pragma unroll
            for (int b = 0; b < 2; ++b)
#pragma unroll
                for (int m = 0; m < 4; ++m)
#pragma unroll
                    for (int n = 0; n < 2; ++n) acc[a][b][m][n] = (f32x4){0.f, 0.f, 0.f, 0.f};
        cur = nxt; cA = nA; cB = nB; ++ui;
        if constexpr (ALIGN_EPI) { if (wr == 1) PG8_BAR; }
    }
    PG8_WAIT_V(0);
    if constexpr (!ALIGN_EPI) { if (wr == 0) PG8_BAR; }
    PG8_BAR;
    if constexpr (Epi::AFTER_DRAIN) { E.fused(acc, cur, wr, wc, fr, fq, lds, wid, lane); S.done(cur); }
#undef PG8_SA
#undef PG8_SB
#undef PG8_STAGE
#undef PG8_LDA
#undef PG8_LDB
#undef PG8_MMA
#undef PG8_WAIT_V
#undef PG8_WAIT_L
#undef PG8_BAR
#undef PG8_SCHED
}
}
namespace pg8 {
constexpr float LOG2E = 1.4426950408889634f;
__device__ __forceinline__ float sigmoid_f(float z) { return __builtin_amdgcn_rcpf(1.0f + __builtin_amdgcn_exp2f(-LOG2E * z)); }
__device__ __forceinline__ float silu_f(float g) { return g * sigmoid_f(g); }
__device__ __forceinline__ float gelu_tanh_f(float x) { const float z = 1.5957691216057308f * (x + 0.044715f * x * x * x); return x * sigmoid_f(z); }
__device__ __forceinline__ float bf16_lo(unsigned w) { return __uint_as_float(w << 16); }
__device__ __forceinline__ float bf16_hi(unsigned w) { return __uint_as_float(w & 0xffff0000u); }

struct EpiSwiGLU {
    static constexpr bool PERM = true, AFTER_DRAIN = false;
    bf16_t* O; int ldc; int blk;
    __device__ __forceinline__ void operator()(const f32x4 (&acc)[2][2][4][2], const Unit& u, int wr, int wc, int fr, int fq) const {
        const int row0 = u.pm * BM + wr * 64 + fr, col0 = u.pn * HALF + wc * 32 + 8 * fq;
#pragma unroll
        for (int ai = 0; ai < 2; ++ai)
#pragma unroll
            for (int m = 0; m < 4; ++m) {
                const int row = row0 + ai * HALF + m * 16;
                bf16_t* p = blk ? O + ((size_t)(row >> 8) * (ldc >> 6) + (col0 >> 6)) * 16384 + (row & 255) * 64 + (col0 & 63) : O + (size_t)row * ldc + col0;
                const f32x4 g0 = acc[ai][0][m][0], g1 = acc[ai][0][m][1], u0 = acc[ai][1][m][0], u1 = acc[ai][1][m][1];
                u32x4 w;
                w.x = cvt_pk_bf16(silu_f(g0[0]) * u0[0], silu_f(g0[1]) * u0[1]); w.y = cvt_pk_bf16(silu_f(g0[2]) * u0[2], silu_f(g0[3]) * u0[3]);
                w.z = cvt_pk_bf16(silu_f(g1[0]) * u1[0], silu_f(g1[1]) * u1[1]); w.w = cvt_pk_bf16(silu_f(g1[2]) * u1[2], silu_f(g1[3]) * u1[3]);
                *(u32x4*)p = w;
#ifndef SWIGLU_NOSB
                __builtin_amdgcn_sched_barrier(0);
#endif
            }
    }
};
struct EpiBf16SS {
    static constexpr bool PERM = true, AFTER_DRAIN = false;
    bf16_t* O; int ldc; float* ss; int ss_ld;
    __device__ __forceinline__ void operator()(const f32x4 (&acc)[2][2][4][2], const Unit& u, int wr, int wc, int fr, int fq) const {
        const int row0 = u.pm * BM + wr * 64 + fr, col0 = u.pn * BM + wc * 32 + 8 * fq;
#pragma unroll
        for (int ai = 0; ai < 2; ++ai)
#pragma unroll
            for (int m = 0; m < 4; ++m) {
                const int row = row0 + ai * HALF + m * 16; bf16_t* p = O + (size_t)row * ldc + col0; float q = 0.f;
#pragma unroll
                for (int bj = 0; bj < 2; ++bj) { const f32x4 v0 = acc[ai][bj][m][0], v1 = acc[ai][bj][m][1];
                    q += (v0[0] * v0[0] + v0[1] * v0[1]) + (v0[2] * v0[2] + v0[3] * v0[3]) + (v1[0] * v1[0] + v1[1] * v1[1]) + (v1[2] * v1[2] + v1[3] * v1[3]);
                    u32x4 w; w.x = cvt_pk_bf16(v0[0], v0[1]); w.y = cvt_pk_bf16(v0[2], v0[3]); w.z = cvt_pk_bf16(v1[0], v1[1]); w.w = cvt_pk_bf16(v1[2], v1[3]);
                    *(u32x4*)(p + bj * HALF) = w; }
                q += __shfl_xor(q, 16); q += __shfl_xor(q, 32);
                if (fq == 0) ss[(size_t)row * ss_ld + u.pn * 4 + wc] = q;
            }
    }
};
struct EpiWin {
    static constexpr bool PERM = true, AFTER_DRAIN = false;
    bf16_t* Q; bf16_t* Kb; bf16_t* Vb; bf16_t* As;
    __device__ __forceinline__ void operator()(const f32x4 (&acc)[2][2][4][2], const Unit& u, int wr, int wc, int fr, int fq) const {
        const int row0 = u.pm * BM + wr * 64 + fr, cl = wc * 32 + 8 * fq;
#pragma unroll
        for (int ai = 0; ai < 2; ++ai)
#pragma unroll
            for (int m = 0; m < 4; ++m) {
                const int row = row0 + ai * HALF + m * 16;
#pragma unroll
                for (int bj = 0; bj < 2; ++bj) { const float qs = (u.pn < 2) ? 0.125f * LOG2E : 1.0f;
                    const f32x4 v0 = acc[ai][bj][m][0] * qs, v1 = acc[ai][bj][m][1] * qs;
                    u32x4 w; w.x = cvt_pk_bf16(v0[0], v0[1]); w.y = cvt_pk_bf16(v0[2], v0[3]); w.z = cvt_pk_bf16(v1[0], v1[1]); w.w = cvt_pk_bf16(v1[2], v1[3]);
                    bf16_t* p;
                    if (u.pn < 2) p = Q + (size_t)row * 512 + u.pn * 256 + bj * HALF + cl;
                    else if (u.pn == 2) p = (bj == 0 ? Kb : Vb) + (size_t)row * 128 + cl;
                    else { const int ch = (u.pn - 3) * 256 + bj * HALF + cl, g = ch >> 4, h0 = ch & 15;
                        p = As + ((size_t)(g * 2048 + (row >> 4)) * 384 + (row & 15) * 16 + h0); }
                    *(u32x4*)p = w; }
            }
    }
};
struct EpiSsmY {
    static constexpr bool PERM = true, AFTER_DRAIN = false;
    bf16_t* YG;
    __device__ __forceinline__ void operator()(const f32x4 (&acc)[2][2][4][2], const Unit& u, int wr, int wc, int fr, int fq) const {
        const int g = u.pn, n0 = (u.pm & 7) * BM + wr * 64 + fr;
#pragma unroll
        for (int ai = 0; ai < 2; ++ai)
#pragma unroll
            for (int m = 0; m < 4; ++m) {
                const int n = n0 + ai * HALF + m * 16;
#pragma unroll
                for (int bj = 0; bj < 2; ++bj) { const f32x4 v0 = acc[ai][bj][m][0], v1 = acc[ai][bj][m][1];
                    const int i = bj * 8 + wc * 2 + (fq >> 1), h0 = (fq & 1) * 8;
                    u32x4 w; w.x = cvt_pk_bf16(gelu_tanh_f(v0[0]), gelu_tanh_f(v0[1])); w.y = cvt_pk_bf16(gelu_tanh_f(v0[2]), gelu_tanh_f(v0[3]));
                    w.z = cvt_pk_bf16(gelu_tanh_f(v1[0]), gelu_tanh_f(v1[1])); w.w = cvt_pk_bf16(gelu_tanh_f(v1[2]), gelu_tanh_f(v1[3]));
                    *(u32x4*)(YG + (size_t)(n * 16 + i) * 512 + g * 16 + h0) = w; __builtin_amdgcn_sched_barrier(0); }
            }
    }
};
struct EpiGlu {
    static constexpr bool PERM = true, AFTER_DRAIN = false;
    const bf16_t* YG; bf16_t* O; const float* bias; float* ss;
    __device__ __forceinline__ void operator()(const f32x4 (&acc)[2][2][4][2], const Unit& u, int wr, int wc, int fr, int fq) const {
        const int row0 = u.pm * BM + wr * 64 + fr, col0 = u.pn * BM + wc * 32 + 8 * fq;
        f32x4 bv[2][2];
#pragma unroll
        for (int bj = 0; bj < 2; ++bj)
#pragma unroll
            for (int n = 0; n < 2; ++n) bv[bj][n] = *(const f32x4*)(bias + col0 + bj * HALF + 4 * n);
#pragma unroll
        for (int ai = 0; ai < 2; ++ai)
#pragma unroll
            for (int m = 0; m < 4; ++m) {
                const int row = row0 + ai * HALF + m * 16; float q = 0.f;
#pragma unroll
                for (int bj = 0; bj < 2; ++bj) { const f32x4 z0 = acc[ai][bj][m][0] + bv[bj][0], z1 = acc[ai][bj][m][1] + bv[bj][1];
                    const u32x4 yw = *(const u32x4*)(YG + (size_t)row * 512 + col0 + bj * HALF);
                    const float o0 = bf16_lo(yw.x) * sigmoid_f(z0[0]), o1 = bf16_hi(yw.x) * sigmoid_f(z0[1]), o2 = bf16_lo(yw.y) * sigmoid_f(z0[2]), o3 = bf16_hi(yw.y) * sigmoid_f(z0[3]);
                    const float o4 = bf16_lo(yw.z) * sigmoid_f(z1[0]), o5 = bf16_hi(yw.z) * sigmoid_f(z1[1]), o6 = bf16_lo(yw.w) * sigmoid_f(z1[2]), o7 = bf16_hi(yw.w) * sigmoid_f(z1[3]);
                    q += (o0 * o0 + o1 * o1) + (o2 * o2 + o3 * o3) + (o4 * o4 + o5 * o5) + (o6 * o6 + o7 * o7);
                    u32x4 w; w.x = cvt_pk_bf16(o0, o1); w.y = cvt_pk_bf16(o2, o3); w.z = cvt_pk_bf16(o4, o5); w.w = cvt_pk_bf16(o6, o7);
                    *(u32x4*)(O + (size_t)row * 512 + col0 + bj * HALF) = w; __builtin_amdgcn_sched_barrier(0); }
                q += __shfl_xor(q, 16); q += __shfl_xor(q, 32);
                if (fq == 0) ss[(size_t)row * 8 + u.pn * 4 + wc] = q;
            }
    }
};
struct OneUnit {
    int pm, pn;
    __device__ __forceinline__ bool next(int i, Unit& u) const { if (i) return false; u.pm = pm; u.pn = pn; return true; }
    __device__ __forceinline__ void a_ready(const Unit&) const {}
    __device__ __forceinline__ void done(const Unit&) const {}
};
struct SsmOrder {
    int G, c;
    __device__ __forceinline__ bool next(int i, Unit& u) const { const int L = i * G + c; if (L >= 256) return false; u.pm = L; u.pn = L >> 3; return true; }
    __device__ __forceinline__ void a_ready(const Unit&) const {}
    __device__ __forceinline__ void done(const Unit&) const {}
};
}
namespace pg8 {
struct RowStats {
    unsigned long long* slot;
    unsigned* tmo;
    int ntn; float scale, eps, mul;
    __device__ __forceinline__ void run(const f32x4 (&v)[2][2][4][2], const Unit& u, int wr, int wc, int fr, int fq, PG8_LAS unsigned char* lds, int wid, int lane) const {
        PG8_LAS float* P = (PG8_LAS float*)lds;
        PG8_LAS float* S = (PG8_LAS float*)(lds + 4096);
#pragma unroll
        for (int ai = 0; ai < 2; ++ai)
#pragma unroll
            for (int m = 0; m < 4; ++m) {
                float s = 0.f;
#pragma unroll
                for (int bj = 0; bj < 2; ++bj)
#pragma unroll
                    for (int n = 0; n < 2; ++n) { const f32x4 x = v[ai][bj][m][n]; s += (x[0] * x[0] + x[1] * x[1]) + (x[2] * x[2] + x[3] * x[3]); }
                s += __shfl_xor(s, 16); s += __shfl_xor(s, 32);
                if (fq == 0) P[(ai * HALF + wr * 64 + m * 16 + fr) * 4 + wc] = s;
            }
        asm volatile("s_waitcnt lgkmcnt(0)" ::: "memory"); __builtin_amdgcn_s_barrier(); asm volatile("" ::: "memory");
        if (lane < 32) {
            const int row = wid * 32 + lane;
            const f32x4 p = *(const PG8_LAS f32x4*)(P + row * 4);
            const float tot = (p[0] + p[1]) + (p[2] + p[3]);
            unsigned long long* sp = slot + (size_t)(u.pm * BM + row);
            const unsigned long long mine = (unsigned long long)(tot * 1048576.0f + 0.5f) + (1ull << 48);
            unsigned long long cur = __hip_atomic_fetch_add(sp, mine, __ATOMIC_RELAXED, __HIP_MEMORY_SCOPE_AGENT) + mine;
            unsigned spins = 0;
            while ((unsigned)(cur >> 48) < (unsigned)ntn) {
                __builtin_amdgcn_s_sleep(1);
                cur = __hip_atomic_load(sp, __ATOMIC_RELAXED, __HIP_MEMORY_SCOPE_AGENT);
                if (++spins > (1u << 20)) { __hip_atomic_store(tmo, 1u, __ATOMIC_RELAXED, __HIP_MEMORY_SCOPE_AGENT); break; }
            }
            const float total = (float)(cur & 0xFFFFFFFFFFFFull) * (1.0f / 1048576.0f);
            S[row] = mul / sqrtf(total * scale + eps);
        }
        asm volatile("s_waitcnt lgkmcnt(0)" ::: "memory"); __builtin_amdgcn_s_barrier(); asm volatile("" ::: "memory");
    }
};
template <bool NORM> struct EpiResNorm {
    static constexpr bool PERM = true, AFTER_DRAIN = false;
    const float* xin; float* xout; bf16_t* H; const float* ga; const float* gpost; const float* gpre; const float* sh; const float* sc; int bstride;
    RowStats st1, st2; PG8_LAS unsigned char* xl; int dbg; const float* dup; float* dupw;
    __device__ __forceinline__ void operator()(const f32x4 (&acc_)[2][2][4][2], const Unit& u, int wr, int wc, int fr, int fq) const {
        f32x4 (&acc)[2][2][4][2] = const_cast<f32x4 (&)[2][2][4][2]>(acc_);
        const int wid = wr * 4 + wc, lane = fq * 16 + fr, b = u.pm >> 3;
#ifdef EPI_STAMPS
#define EPI_STAMP(k) do { if (dbg && blockIdx.x == 0 && wid == 0 && lane == 0) { volatile PG8_LAS unsigned* q_ = (volatile PG8_LAS unsigned*)(xl + 12288 + 64 + (40 + (k)) * 4); if (*q_ == 0u) *q_ = (unsigned)__builtin_amdgcn_s_memrealtime(); else q_[8] = (unsigned)__builtin_amdgcn_s_memrealtime(); } } while (0)
#else
#define EPI_STAMP(k) do {} while (0)
#endif
        EPI_STAMP(0);
        const PG8_LAS float* S = (const PG8_LAS float*)(xl + 4096);
        const int col0 = u.pn * BM + wc * 32 + 8 * fq;
        const size_t rbase = (size_t)(u.pm * BM + wr * 64 + fr) * 1024 + col0;
#if defined(EPI_DUP_LD)
#define EPI_DUPLD(m) do { if (dbg) { const f32x4 d0_ = *(const f32x4*)(pin_ + (dup - xin)); bs[2 * (m)] += d0_ * 0.0f; } } while (0)
#else
#define EPI_DUPLD(m) do {} while (0)
#endif
#if defined(EPI_DUP_ST)
#define EPI_DUPST(m) do { if (dbg) { *(f32x4*)(pout_ + (dupw - xout)) = acc[ai_][bj_][m][0]; *(f32x4*)(pout_ + (dupw - xout) + 4) = acc[ai_][bj_][m][1]; } } while (0)
#else
#define EPI_DUPST(m) do {} while (0)
#endif
#define RN_LOAD(k) do { const float* pin_ = xin + rbase + (size_t)(((k) & 1) * HALF) * 1024 + ((k) >> 1) * HALF; _Pragma("unroll") for (int m = 0; m < 4; ++m) { \
            bs[2 * m] = *(const f32x4*)pin_; bs[2 * m + 1] = *(const f32x4*)(pin_ + 4); EPI_DUPLD(m); pin_ += 16 * 1024; asm volatile("" : "+v"(pin_)); } } while (0)
#define RN_COMP(k) do { const int ai_ = (k) & 1, bj_ = (k) >> 1, c_ = col0 + bj_ * HALF; \
            const f32x4 cv0_ = *(const f32x4*)(ga + (size_t)b * bstride + c_) * *(const f32x4*)(gpost + c_), cv1_ = *(const f32x4*)(ga + (size_t)b * bstride + c_ + 4) * *(const f32x4*)(gpost + c_ + 4); \
            _Pragma("unroll") for (int m = 0; m < 4; ++m) { const float sr_ = sr[ai_][m]; \
                acc[ai_][bj_][m][0] = bs[2 * m] + cv0_ * acc[ai_][bj_][m][0] * sr_; acc[ai_][bj_][m][1] = bs[2 * m + 1] + cv1_ * acc[ai_][bj_][m][1] * sr_; } \
            asm volatile("" : "+v"(acc[ai_][bj_][0][0]), "+v"(acc[ai_][bj_][0][1]), "+v"(acc[ai_][bj_][1][0]), "+v"(acc[ai_][bj_][1][1]), "+v"(acc[ai_][bj_][2][0]), "+v"(acc[ai_][bj_][2][1]), "+v"(acc[ai_][bj_][3][0]), "+v"(acc[ai_][bj_][3][1])); \
            __builtin_amdgcn_sched_barrier(0); } while (0)
#define RN_STORE(k) do { const int ai_ = (k) & 1, bj_ = (k) >> 1; float* pout_ = xout + rbase + (size_t)(ai_ * HALF) * 1024 + bj_ * HALF; \
            _Pragma("unroll") for (int m = 0; m < 4; ++m) { *(f32x4*)pout_ = acc[ai_][bj_][m][0]; *(f32x4*)(pout_ + 4) = acc[ai_][bj_][m][1]; EPI_DUPST(m); pout_ += 16 * 1024; asm volatile("" : "+v"(pout_)); } \
            asm volatile("" ::: "memory"); __builtin_amdgcn_sched_barrier(0); } while (0)
        {
            f32x4 bs[8];
            RN_LOAD(0);
            st1.run(acc, u, wr, wc, fr, fq, xl, wid, lane);
            float sr[2][4];
#pragma unroll
            for (int ai = 0; ai < 2; ++ai)
#pragma unroll
                for (int m = 0; m < 4; ++m) sr[ai][m] = S[ai * HALF + wr * 64 + m * 16 + fr];
            EPI_STAMP(1);
            RN_COMP(0); RN_LOAD(1); asm volatile("" ::: "memory"); __builtin_amdgcn_sched_barrier(0); RN_STORE(0);
            RN_COMP(1); RN_LOAD(2); asm volatile("" ::: "memory"); __builtin_amdgcn_sched_barrier(0); RN_STORE(1);
            RN_COMP(2); RN_LOAD(3); asm volatile("" ::: "memory"); __builtin_amdgcn_sched_barrier(0); RN_STORE(2);
            RN_COMP(3); RN_STORE(3);
            EPI_STAMP(2);
        }
#undef RN_LOAD
#undef RN_COMP
#undef RN_STORE
        if (NORM) {
            st2.run(acc, u, wr, wc, fr, fq, xl, wid, lane);
            EPI_STAMP(3);
            float sr[2][4];
#pragma unroll
            for (int ai = 0; ai < 2; ++ai)
#pragma unroll
                for (int m = 0; m < 4; ++m) sr[ai][m] = S[ai * HALF + wr * 64 + m * 16 + fr];
#pragma unroll
            for (int bj = 0; bj < 2; ++bj) { const int c = col0 + bj * HALF; const size_t bo = (size_t)b * bstride + c;
                const f32x4 gv0 = *(const f32x4*)(gpre + c) * (1.0f + *(const f32x4*)(sc + bo)), gv1 = *(const f32x4*)(gpre + c + 4) * (1.0f + *(const f32x4*)(sc + bo + 4));
                const f32x4 hv0 = *(const f32x4*)(sh + bo), hv1 = *(const f32x4*)(sh + bo + 4);
                bf16_t* ph = H + rbase + bj * HALF;
#pragma unroll
                for (int ai = 0; ai < 2; ++ai)
#pragma unroll
                    for (int m = 0; m < 4; ++m) { const f32x4 o0 = acc[ai][bj][m][0] * sr[ai][m] * gv0 + hv0, o1 = acc[ai][bj][m][1] * sr[ai][m] * gv1 + hv1;
                        u32x4 w; w.x = cvt_pk_bf16(o0[0], o0[1]); w.y = cvt_pk_bf16(o0[2], o0[3]); w.z = cvt_pk_bf16(o1[0], o1[1]); w.w = cvt_pk_bf16(o1[2], o1[3]);
                        *(u32x4*)ph = w; ph += (m == 3 ? (HALF - 48) : 16) * 1024; asm volatile("" : "+v"(ph)); }
                asm volatile("" ::: "memory"); __builtin_amdgcn_sched_barrier(0); }
        }
        EPI_STAMP(4);
    }
};
struct EpiGluNorm {
    static constexpr bool PERM = true, AFTER_DRAIN = false;
    const bf16_t* YG; bf16_t* MX; const float* bias; const float* g; RowStats st; PG8_LAS unsigned char* xl;
    __device__ __forceinline__ void operator()(const f32x4 (&acc_)[2][2][4][2], const Unit& u, int wr, int wc, int fr, int fq) const {
        f32x4 (&acc)[2][2][4][2] = const_cast<f32x4 (&)[2][2][4][2]>(acc_);
        const int wid = wr * 4 + wc, lane = fq * 16 + fr;
        const PG8_LAS float* S = (const PG8_LAS float*)(xl + 4096);
        const int row0 = u.pm * BM + wr * 64 + fr, col0 = u.pn * BM + wc * 32 + 8 * fq;
#pragma unroll
        for (int bj = 0; bj < 2; ++bj) {
            const f32x4 bv0 = *(const f32x4*)(bias + col0 + bj * HALF), bv1 = *(const f32x4*)(bias + col0 + bj * HALF + 4);
            u32x4 yw[2][4]; const bf16_t* py = YG + (size_t)row0 * 512 + col0 + bj * HALF;
#pragma unroll
            for (int ai = 0; ai < 2; ++ai)
#pragma unroll
                for (int m = 0; m < 4; ++m) { yw[ai][m] = *(const u32x4*)py; py += (m == 3 ? (HALF - 48) : 16) * 512; asm volatile("" : "+v"(py)); }
#pragma unroll
            for (int ai = 0; ai < 2; ++ai)
#pragma unroll
                for (int m = 0; m < 4; ++m) { const f32x4 z0 = acc[ai][bj][m][0] + bv0, z1 = acc[ai][bj][m][1] + bv1; const u32x4 y = yw[ai][m];
                    acc[ai][bj][m][0] = (f32x4){bf16_lo(y.x) * sigmoid_f(z0[0]), bf16_hi(y.x) * sigmoid_f(z0[1]), bf16_lo(y.y) * sigmoid_f(z0[2]), bf16_hi(y.y) * sigmoid_f(z0[3])};
                    acc[ai][bj][m][1] = (f32x4){bf16_lo(y.z) * sigmoid_f(z1[0]), bf16_hi(y.z) * sigmoid_f(z1[1]), bf16_lo(y.w) * sigmoid_f(z1[2]), bf16_hi(y.w) * sigmoid_f(z1[3])}; }
            asm volatile("" ::: "memory"); __builtin_amdgcn_sched_barrier(0);
        }
        st.run(acc, u, wr, wc, fr, fq, xl, wid, lane);
        float sr[2][4];
#pragma unroll
        for (int ai = 0; ai < 2; ++ai)
#pragma unroll
            for (int m = 0; m < 4; ++m) sr[ai][m] = S[ai * HALF + wr * 64 + m * 16 + fr];
#pragma unroll
        for (int bj = 0; bj < 2; ++bj) {
            const f32x4 gv0 = *(const f32x4*)(g + col0 + bj * HALF), gv1 = *(const f32x4*)(g + col0 + bj * HALF + 4);
            bf16_t* pm_ = MX + (size_t)row0 * 1024 + 512 + col0 + bj * HALF;
#pragma unroll
            for (int ai = 0; ai < 2; ++ai)
#pragma unroll
                for (int m = 0; m < 4; ++m) { const f32x4 o0 = acc[ai][bj][m][0] * sr[ai][m] * gv0, o1 = acc[ai][bj][m][1] * sr[ai][m] * gv1;
                    u32x4 w; w.x = cvt_pk_bf16(o0[0], o0[1]); w.y = cvt_pk_bf16(o0[2], o0[3]); w.z = cvt_pk_bf16(o1[0], o1[1]); w.w = cvt_pk_bf16(o1[2], o1[3]);
                    *(u32x4*)pm_ = w; pm_ += (m == 3 ? (HALF - 48) : 16) * 1024; asm volatile("" : "+v"(pm_)); }
            asm volatile("" ::: "memory"); __builtin_amdgcn_sched_barrier(0);
        }
    }
};
}
#ifndef DOWN_BLK
#define DOWN_BLK 1
#endif
constexpr int NWAVES = 8, NTHR = 512;
constexpr int NB = 16, SEQ = 2048, DM = 1024, M = NB * SEQ, DFF = 2816, DIN = 1280, DATT = 512, DSSM = 512, NGRP = 32, NST = 64, NMOD = 9 * DM;
constexpr int KSS = 384;
constexpr float EPS = 1e-6f;
constexpr size_t MiB = 1u << 20;
constexpr size_t al256(size_t x) { return (x + 255) & ~(size_t)255; }
constexpr size_t WS_CTL = 0, CTL_ZERO_BYTES = 32768;
constexpr size_t WS_XB = MiB;
constexpr size_t WS_W1GU = WS_XB + 6 * (size_t)32768 * 16;
constexpr size_t WS_W1D  = WS_W1GU + al256((size_t)2 * DFF * DM * 2);
constexpr size_t WS_W2GU = WS_W1D + al256((size_t)DM * DFF * 2);
constexpr size_t WS_W2D  = WS_W2GU + al256((size_t)2 * DFF * DM * 2);
constexpr size_t WS_WIN  = WS_W2D + al256((size_t)DM * DFF * 2);
constexpr size_t WS_WGLU = WS_WIN + al256((size_t)DIN * DM * 2);
constexpr size_t WS_WOUT = WS_WGLU + al256((size_t)DSSM * DSSM * 2);
constexpr size_t WS_TW   = WS_WOUT + al256((size_t)DM * DM * 2);
constexpr size_t WS_WS   = WS_TW + al256((size_t)NGRP * 256 * KSS * 2);
constexpr size_t WS_KT   = WS_WS + al256((size_t)NGRP * 128 * 256 * 2);
constexpr size_t WS_A16  = WS_KT + al256((size_t)NGRP * 16 * 256 * 4);
constexpr size_t WS_MOD  = WS_A16 + al256((size_t)2 * NGRP * NST * 4);
constexpr size_t WS_FSS  = WS_MOD + al256((size_t)NB * NMOD * 4);
constexpr size_t WS_SSS  = WS_FSS + al256((size_t)M * 16 * 4);
constexpr size_t WS_H    = al256(WS_SSS + (size_t)M * 8 * 4 + MiB);
constexpr size_t WS_F    = WS_H + (size_t)M * DM * 2;
constexpr size_t WS_SSMR = WS_F + (size_t)M * DM * 2;
constexpr size_t WS_ACT  = WS_SSMR + (size_t)M * DSSM * 2;
constexpr size_t WS_Q    = WS_ACT;
constexpr size_t WS_K    = WS_Q + (size_t)M * DATT * 2;
constexpr size_t WS_V    = WS_K + (size_t)M * 128 * 2;
constexpr size_t WS_AS   = WS_V + (size_t)M * 128 * 2;
constexpr size_t WS_S    = WS_AS + (size_t)NGRP * 2048 * KSS * 2;
constexpr size_t WS_YG   = WS_S + (size_t)NGRP * 2048 * 128 * 4;
constexpr size_t WS_MIXEND = WS_YG + (size_t)M * DSSM * 2;
constexpr size_t WS_END  = WS_ACT + (size_t)M * DFF * 2;
static_assert(WS_MIXEND <= WS_END, "mixer temporaries must fit inside ACT");
constexpr int LDS_BYTES = 147456;
constexpr int LDS_MISC_OFF = 143360;
constexpr int CW_BAR = 1024;
constexpr int CW_TMO = 0, CW_SEAM = 8192, SEAM_BANK = 8192;
constexpr int LDS_X_OFF = 131072;

#define GAS __attribute__((address_space(1)))
#define LAS __attribute__((address_space(3)))
typedef unsigned short bf16;
typedef unsigned v4u __attribute__((ext_vector_type(4)));
typedef unsigned v2u __attribute__((ext_vector_type(2)));
typedef float f32x4 __attribute__((ext_vector_type(4)));
typedef float f32x16 __attribute__((ext_vector_type(16)));
typedef short bf16x8 __attribute__((ext_vector_type(8)));
#define LDS_WAIT() asm volatile("s_waitcnt lgkmcnt(0)" ::: "memory")
__device__ __forceinline__ unsigned f2bf(float f) { unsigned u = __builtin_bit_cast(unsigned, f); return (u + 0x7fffu + ((u >> 16) & 1u)) >> 16; }
__device__ __forceinline__ unsigned pk2(float lo, float hi) { return pg8::cvt_pk_bf16(lo, hi); }
__device__ __forceinline__ float bflo(unsigned w) { return __uint_as_float(w << 16); }
__device__ __forceinline__ float bfhi(unsigned w) { return __uint_as_float(w & 0xffff0000u); }
__device__ __forceinline__ float wave_sum(float v) {
#pragma unroll
    for (int o = 1; o < 64; o <<= 1) v += __shfl_xor(v, o);
    return v;
}

#define XB_TMO      128
#define XB_XCNT(j)  (256  + 64 * (j))
#define XB_XSUB(j)  (1280 + 64 * (j))
#define XB_XGEN(j)  (2304 + 64 * (j))
#define XB_TOP      3328
#define XB_TOPGEN   3392
#define XCD_BAR_WORDS 3456
#define XB_SPIN_CAP (1u << 18)

__device__ __forceinline__ unsigned xb_ld(unsigned* p)              { return __hip_atomic_load(p, __ATOMIC_RELAXED, __HIP_MEMORY_SCOPE_AGENT); }
__device__ __forceinline__ unsigned xb_add(unsigned* p, unsigned v) { return __hip_atomic_fetch_add(p, v, __ATOMIC_RELAXED, __HIP_MEMORY_SCOPE_AGENT); }
__device__ __forceinline__ unsigned xb_xcc_id() { return (unsigned)__builtin_amdgcn_s_getreg((3 << 11) | 20) & 0xFu; }
#define XB_SPIN(cond, bar) do { unsigned _sp = 0; while (cond) { __builtin_amdgcn_s_sleep(1); \
    if ((++_sp & 255u) == 0u) { if (xb_ld(&(bar)[XB_TMO])) break; if (_sp > XB_SPIN_CAP) { atomicAdd(&(bar)[XB_TMO], 1u); break; } } } } while (0)

struct XcdBarrier {
    unsigned* bar; unsigned x;
    volatile LAS unsigned* st;
};

__device__ __forceinline__ XcdBarrier xcd_barrier_post(unsigned* bar, volatile LAS unsigned* st) {
    XcdBarrier b; b.bar = bar; b.x = xb_xcc_id(); b.st = st;
    if (threadIdx.x == 0) (void)xb_add(&bar[XB_XCNT(b.x)], 1u);
    return b;
}
__device__ __forceinline__ void xcd_barrier_complete(unsigned* bar, unsigned x, unsigned& nloc, unsigned& nx) {
    const unsigned G = gridDim.x * gridDim.y * gridDim.z;
    unsigned sum, cnt, mine, sp = 0u;
    for (;;) {
        sum = 0u; cnt = 0u; mine = 0u;
#pragma unroll
        for (unsigned j = 0; j < 16; ++j) { const unsigned c = xb_ld(&bar[XB_XCNT(j)]); sum += c; cnt += (c > 0u) ? 1u : 0u; mine = (j == x) ? c : mine; }
        if (sum == G) break;
        __builtin_amdgcn_s_sleep(1);
        if ((++sp & 255u) == 0u) { if (xb_ld(&bar[XB_TMO])) break; if (sp > XB_SPIN_CAP) { atomicAdd(&bar[XB_TMO], 1u); break; } }
    }
    nloc = mine > 0u ? mine : 1u; nx = cnt > 0u ? cnt : 1u;
}

__device__ __forceinline__ void xcd_barrier(const XcdBarrier& b) {
    asm volatile("s_waitcnt vmcnt(0)" ::: "memory");
    __syncthreads();
    if (threadIdx.x == 0) {
        unsigned* bar = b.bar;
        __builtin_amdgcn_s_waitcnt(0);
        unsigned nloc = b.st[0], nx = b.st[1];
        if (nloc == 0u) { xcd_barrier_complete(bar, b.x, nloc, nx); b.st[0] = nloc; b.st[1] = nx; }
        const unsigned old = xb_add(&bar[XB_XSUB(b.x)], 1u);
        const unsigned gen = old / nloc;
        if (old + 1u == (gen + 1u) * nloc) {
            __builtin_amdgcn_fence(__ATOMIC_RELEASE, "agent");
            asm volatile("s_waitcnt vmcnt(0)" ::: "memory");
            const unsigned og = xb_add(&bar[XB_TOP], 1u);
            const unsigned tg = og / nx;
            if (og + 1u == (tg + 1u) * nx) xb_add(&bar[XB_TOPGEN], 1u);
            else XB_SPIN(xb_ld(&bar[XB_TOPGEN]) == tg, bar);
            __builtin_amdgcn_fence(__ATOMIC_ACQUIRE, "agent");
            xb_add(&bar[XB_XGEN(b.x)], 1u);
            asm volatile("s_waitcnt vmcnt(0)" ::: "memory");
        } else {
            XB_SPIN(xb_ld(&bar[XB_XGEN(b.x)]) == gen, bar);
            __builtin_amdgcn_fence(__ATOMIC_ACQUIRE, "agent");
            asm volatile("s_waitcnt vmcnt(0)" ::: "memory");
        }
    }
    __syncthreads();
}

struct Args { const float* in[31]; float* out; unsigned char* ws; };
enum { I_X = 0, I_C, I_WADA, I_BADA, I_GPRE1, I_GPOST1, I_W1G, I_W1U, I_W1D, I_GPREM, I_GPOSTM, I_WIN, I_SINKS, I_ARE, I_AIM, I_LSTEP, I_BRE, I_BIM, I_CRE, I_CIM, I_SSMD, I_WGLU, I_BGLU,
       I_GATT, I_GSSM, I_WOUT, I_GPRE2, I_GPOST2, I_W2G, I_W2U, I_W2D };

struct Frame {
    LAS unsigned char* lds; int tid, lane, wave, G;
};

template <int MAP, int BLK = 0> __device__ __forceinline__ void p0_transpose_item(const float* W, int K, int N, bf16* WT, LAS float* scr, int item, int lane) {
    const int nblk = N / 32, kb = item / nblk, nb = item % nblk, k0 = 64 * kb, n0 = 32 * nb;
    float wv[32];
#pragma unroll
    for (int i = 0; i < 32; ++i) wv[i] = W[(size_t)(k0 + 2 * i + (lane >> 5)) * N + n0 + (lane & 31)];
#pragma unroll
    for (int i = 0; i < 32; ++i) scr[(2 * i + (lane >> 5)) * 33 + (lane & 31)] = wv[i];
    LDS_WAIT(); asm volatile("" ::: "memory");
    const int c = lane & 7;
    const int r0 = (MAP == 0) ? n0 : ((n0 >> 7) * 256 + (n0 & 127) + (MAP == 2 ? 128 : 0));
#pragma unroll
    for (int j = 0; j < 4; ++j) { const int n = (lane >> 3) + 8 * j; const LAS float* s = scr + (8 * c) * 33 + n;
        v4u o; o.x = pk2(s[0 * 33], s[1 * 33]); o.y = pk2(s[2 * 33], s[3 * 33]); o.z = pk2(s[4 * 33], s[5 * 33]); o.w = pk2(s[6 * 33], s[7 * 33]);
        const int row = r0 + n;
        if (BLK) *(GAS v4u*)(WT + ((size_t)(row >> 8) * (K >> 6) + (k0 >> 6)) * 16384 + (row & 255) * 64 + 8 * c) = o;
        else *(GAS v4u*)(WT + (size_t)row * K + k0 + 8 * c) = o; }
    LDS_WAIT(); asm volatile("" ::: "memory");
}
__device__ __forceinline__ void p0_zero_slots(Frame& F, const Args& a) {
    int tid_l = F.wave * 64 + (int)__builtin_amdgcn_mbcnt_hi(~0u, __builtin_amdgcn_mbcnt_lo(~0u, 0u)); asm volatile("" : "+v"(tid_l)); const int lane_l = tid_l & 63;
    v4u* z = (v4u*)(a.ws + WS_XB);
    for (int i = blockIdx.x * NTHR + tid_l; i < 6 * M / 2; i += F.G * NTHR) z[i] = (v4u){0u, 0u, 0u, 0u};
}
template <int PART> __device__ __forceinline__ void p0_weights(Frame& F, const Args& a) {
    int tid_l = F.wave * 64 + (int)__builtin_amdgcn_mbcnt_hi(~0u, __builtin_amdgcn_mbcnt_lo(~0u, 0u)); asm volatile("" : "+v"(tid_l)); const int lane_l = tid_l & 63;
    LAS float* scr = (LAS float*)(F.lds + F.wave * 16384);
    int first, nblk;
    if (PART == 0) { first = (NMOD / 32 > F.G && NMOD / 32 < 2 * F.G) ? NMOD / 32 - F.G : 0; nblk = F.G - first; }
    else { const int busy = (M / 256) * (DIN / 256) - 2 * F.G; first = (busy > 0 && busy < F.G) ? busy : 0; nblk = F.G - first; }
    if ((int)blockIdx.x < first) return;
    const int gw = ((int)blockIdx.x - first) * NWAVES + F.wave, NGW = nblk * NWAVES;
    unsigned char* ws = a.ws;
    constexpr int I_GU = (DM / 64) * (DFF / 32), I_D = (DFF / 64) * (DM / 32), I_IN = (DM / 64) * (DIN / 32), I_GL = (DSSM / 64) * (DSSM / 32), I_O = (DM / 64) * (DM / 32);
    if (PART == 0) {
        constexpr int NITEMS = 2 * I_GU + I_D + I_IN;
        for (int it = gw; it < NITEMS; it += NGW) {
            int r = it;
            if (r < I_GU) { p0_transpose_item<1>(a.in[I_W1G], DM, DFF, (bf16*)(ws + WS_W1GU), scr, r, lane_l); continue; } r -= I_GU;
            if (r < I_GU) { p0_transpose_item<2>(a.in[I_W1U], DM, DFF, (bf16*)(ws + WS_W1GU), scr, r, lane_l); continue; } r -= I_GU;
            if (r < I_D) { p0_transpose_item<0, DOWN_BLK>(a.in[I_W1D], DFF, DM, (bf16*)(ws + WS_W1D), scr, r, lane_l); continue; } r -= I_D;
            p0_transpose_item<0>(a.in[I_WIN], DM, DIN, (bf16*)(ws + WS_WIN), scr, r, lane_l);
        }
    } else {
        constexpr int NITEMS = 2 * I_GU + I_D + I_GL + I_O;
        for (int it = gw; it < NITEMS; it += NGW) {
            int r = it;
            if (r < I_GU) { p0_transpose_item<1>(a.in[I_W2G], DM, DFF, (bf16*)(ws + WS_W2GU), scr, r, lane_l); continue; } r -= I_GU;
            if (r < I_GU) { p0_transpose_item<2>(a.in[I_W2U], DM, DFF, (bf16*)(ws + WS_W2GU), scr, r, lane_l); continue; } r -= I_GU;
            if (r < I_D) { p0_transpose_item<0, DOWN_BLK>(a.in[I_W2D], DFF, DM, (bf16*)(ws + WS_W2D), scr, r, lane_l); continue; } r -= I_D;
            if (r < I_GL) { p0_transpose_item<0>(a.in[I_WGLU], DSSM, DSSM, (bf16*)(ws + WS_WGLU), scr, r, lane_l); continue; } r -= I_GL;
            p0_transpose_item<0>(a.in[I_WOUT], DM, DM, (bf16*)(ws + WS_WOUT), scr, r, lane_l);
        }
    }
}
__device__ __forceinline__ void p0_mod(Frame& F, const Args& a) {
    int tid_l = F.wave * 64 + (int)__builtin_amdgcn_mbcnt_hi(~0u, __builtin_amdgcn_mbcnt_lo(~0u, 0u)); asm volatile("" : "+v"(tid_l)); const int lane_l = tid_l & 63;
    LAS float* cact = (LAS float*)F.lds;
    LAS float* red = (LAS float*)(F.lds + 81920);
    const float* c = a.in[I_C]; const float* W = a.in[I_WADA]; const float* bias = a.in[I_BADA]; float* mod = (float*)(a.ws + WS_MOD);
    {
        float cv[32];
#pragma unroll
        for (int j = 0; j < 32; ++j) cv[j] = c[j * NTHR + tid_l];
#pragma unroll
        for (int j = 0; j < 32; ++j) { const int i = j * NTHR + tid_l, b = i >> 10, k = i & 1023; const float v = cv[j]; cact[k * 20 + b] = v / (1.0f + __expf(-v)); }
    }
    __syncthreads();
    const int cg = lane_l & 7, rg = lane_l >> 3;
    for (int tile = blockIdx.x; tile < NMOD / 32; tile += 2 * F.G) {
        const int tileB = tile + F.G; const bool hasB = tileB < NMOD / 32;
        f32x4 w[2][16];
        { const float* wp = W + (size_t)(F.wave * 128 + rg) * NMOD + tile * 32 + 4 * cg;
#pragma unroll
          for (int i = 0; i < 16; ++i) w[0][i] = *(const f32x4*)(wp + (size_t)i * 8 * NMOD); }
        if (hasB) { const float* wp = W + (size_t)(F.wave * 128 + rg) * NMOD + tileB * 32 + 4 * cg;
#pragma unroll
          for (int i = 0; i < 16; ++i) w[1][i] = *(const f32x4*)(wp + (size_t)i * 8 * NMOD); }
#pragma unroll
        for (int t = 0; t < 2; ++t) {
            if (t == 1 && !hasB) break;
            const int n0 = (t == 0 ? tile : tileB) * 32;
            f32x4 acc[16];
#pragma unroll
            for (int b = 0; b < 16; ++b) acc[b] = (f32x4){0.f, 0.f, 0.f, 0.f};
#pragma unroll
            for (int i = 0; i < 16; ++i) {
                const LAS f32x4* cp = (const LAS f32x4*)(cact + (F.wave * 128 + i * 8 + rg) * 20);
                const f32x4 c0 = cp[0], c1 = cp[1], c2 = cp[2], c3 = cp[3]; const f32x4 wv = w[t][i];
                acc[0] += wv * c0[0]; acc[1] += wv * c0[1]; acc[2] += wv * c0[2]; acc[3] += wv * c0[3];
                acc[4] += wv * c1[0]; acc[5] += wv * c1[1]; acc[6] += wv * c1[2]; acc[7] += wv * c1[3];
                acc[8] += wv * c2[0]; acc[9] += wv * c2[1]; acc[10] += wv * c2[2]; acc[11] += wv * c2[3];
                acc[12] += wv * c3[0]; acc[13] += wv * c3[1]; acc[14] += wv * c3[2]; acc[15] += wv * c3[3];
            }
            f32x4 s8[8], s4[4], s2[2];
            { const bool up = (lane_l & 32) != 0;
#pragma unroll
              for (int i = 0; i < 8; ++i) { const f32x4 keep = up ? acc[8 + i] : acc[i], send = up ? acc[i] : acc[8 + i]; f32x4 rcv;
#pragma unroll
                  for (int e = 0; e < 4; ++e) rcv[e] = __shfl_xor(send[e], 32);
                  s8[i] = keep + rcv; } }
            { const bool up = (lane_l & 16) != 0;
#pragma unroll
              for (int i = 0; i < 4; ++i) { const f32x4 keep = up ? s8[4 + i] : s8[i], send = up ? s8[i] : s8[4 + i]; f32x4 rcv;
#pragma unroll
                  for (int e = 0; e < 4; ++e) rcv[e] = __shfl_xor(send[e], 16);
                  s4[i] = keep + rcv; } }
            { const bool up = (lane_l & 8) != 0;
#pragma unroll
              for (int i = 0; i < 2; ++i) { const f32x4 keep = up ? s4[2 + i] : s4[i], send = up ? s4[i] : s4[2 + i]; f32x4 rcv;
#pragma unroll
                  for (int e = 0; e < 4; ++e) rcv[e] = __shfl_xor(send[e], 8);
                  s2[i] = keep + rcv; } }
            { const int b0 = ((lane_l >> 5) & 1) * 8 + ((lane_l >> 4) & 1) * 4 + ((lane_l >> 3) & 1) * 2;
#pragma unroll
              for (int i = 0; i < 2; ++i) *(LAS f32x4*)(red + (F.wave * 16 + b0 + i) * 32 + 4 * cg) = s2[i]; }
            __syncthreads();
            { const int b = tid_l >> 5, n = tid_l & 31; float s = bias[n0 + n];
#pragma unroll
              for (int wv = 0; wv < 8; ++wv) s += red[(wv * 16 + b) * 32 + n];
              mod[(size_t)b * NMOD + n0 + n] = s; }
            __syncthreads();
        }
    }
}
__device__ __forceinline__ void p0_ssm(Frame& F, const Args& a) {
    int tid_l = F.wave * 64 + (int)__builtin_amdgcn_mbcnt_hi(~0u, __builtin_amdgcn_mbcnt_lo(~0u, 0u)); asm volatile("" : "+v"(tid_l)); const int lane_l = tid_l & 63;
    LAS float* pwr = (LAS float*)F.lds;
    LAS float* pwi = pwr + 17 * 64;
    LAS float* cfr = pwi + 17 * 64;
    LAS float* cfi = cfr + 64;
    LAS float* cre = cfi + 64;
    LAS float* cim = cre + 1024;
    LAS float* bbr = cim + 1024;
    LAS float* bbi = bbr + 1024;
    const float* a_re = a.in[I_ARE]; const float* a_im = a.in[I_AIM]; const float* lstep = a.in[I_LSTEP];
    const float* b_re = a.in[I_BRE]; const float* b_im = a.in[I_BIM]; const float* c_re = a.in[I_CRE]; const float* c_im = a.in[I_CIM]; const float* dsk = a.in[I_SSMD];
    bf16* Tw = (bf16*)(a.ws + WS_TW); bf16* WS = (bf16*)(a.ws + WS_WS); float* Kt = (float*)(a.ws + WS_KT); float* A16 = (float*)(a.ws + WS_A16);
    for (int wi = blockIdx.x; wi < 256; wi += F.G) {
        const int g = wi >> 3, tp = wi & 7;
        __syncthreads();
        for (int i = tid_l; i < 1024; i += NTHR) { cre[i] = c_re[g * 1024 + i]; cim[i] = c_im[g * 1024 + i]; bbr[i] = b_re[g * 1024 + i]; bbi[i] = b_im[g * 1024 + i]; }
        const float dt = expf(lstep[g]);
        for (int i = tid_l; i < 17 * 64; i += NTHR) { const int tau = i >> 6, p = i & 63; const float are = a_re[g * 64 + p], aim = a_im[g * 64 + p];
            const float mag = expf(are * dt * (float)tau); float s, c; sincosf(aim * dt * (float)tau, &s, &c); pwr[i] = mag * c; pwi[i] = mag * s; }
        if (tid_l < 64) { const int p = tid_l; const float are = a_re[g * 64 + p], aim = a_im[g * 64 + p];
            const float mag = expf(are * dt); float s, c; sincosf(aim * dt, &s, &c); const float lr = mag * c - 1.0f, li = mag * s, den = are * are + aim * aim;
            cfr[p] = (lr * are + li * aim) / den; cfi[p] = (li * are - lr * aim) / den; }
        __syncthreads();
        for (int i = tid_l; i < 1024; i += NTHR) { const int p = i >> 4; const float br = bbr[i], bi = bbi[i]; bbr[i] = cfr[p] * br - cfi[p] * bi; bbi[i] = cfr[p] * bi + cfi[p] * br; }
        __syncthreads();
        {
            const int tau = 2 * tp + (tid_l >> 8), h = (tid_l >> 4) & 15, hp = tid_l & 15; float acc = 0.f;
#pragma unroll 8
            for (int p = 0; p < 64; ++p) {
                const float cr = cre[h * 64 + p], ci = cim[h * 64 + p], br = bbr[p * 16 + hp], bi = bbi[p * 16 + hp];
                const float pr = pwr[tau * 64 + p], pi = pwi[tau * 64 + p];
                const float wr_ = pr * br - pi * bi, wi_ = pr * bi + pi * br;
                acc += cr * wr_ - ci * wi_; }
            if (tau == 0 && h == hp) acc += dsk[g * 16 + h];
            Kt[((g * 16 + tau) * 16 + h) * 16 + hp] = acc;
        }
        for (int e = tid_l; e < 2048; e += NTHR) {
            const int i = 2 * tp + (e >> 10), h = (e >> 6) & 15, p = e & 63;
            const float cr = cre[h * 64 + p], ci = cim[h * 64 + p], pr = pwr[(i + 1) * 64 + p], pi = pwi[(i + 1) * 64 + p];
            bf16* row = Tw + (size_t)(g * 256 + i * 16 + h) * KSS;
            row[256 + p] = (bf16)f2bf(cr * pr - ci * pi); row[320 + p] = (bf16)f2bf(-(cr * pi + ci * pr)); }
        for (int e = tid_l; e < 2048; e += NTHR) {
            const int j = 2 * tp + (e >> 10), p = (e >> 4) & 63, hp = e & 15;
            const float br = bbr[p * 16 + hp], bi = bbi[p * 16 + hp];
            const float pr = pwr[(15 - j) * 64 + p], pi = pwi[(15 - j) * 64 + p];
            WS[(size_t)(g * 128 + p) * 256 + j * 16 + hp] = (bf16)f2bf(pr * br - pi * bi);
            WS[(size_t)(g * 128 + 64 + p) * 256 + j * 16 + hp] = (bf16)f2bf(pr * bi + pi * br); }
        if (tp == 0 && tid_l < 64) { A16[g * 64 + tid_l] = pwr[16 * 64 + tid_l]; A16[NGRP * 64 + g * 64 + tid_l] = pwi[16 * 64 + tid_l]; }
    }
    __syncthreads();
}
__device__ __forceinline__ void p1_toeplitz(Frame& F, const Args& a) {
    int tid_l = F.wave * 64 + (int)__builtin_amdgcn_mbcnt_hi(~0u, __builtin_amdgcn_mbcnt_lo(~0u, 0u)); asm volatile("" : "+v"(tid_l)); const int lane_l = tid_l & 63;
    const float* Kt = (const float*)(a.ws + WS_KT); bf16* Tw = (bf16*)(a.ws + WS_TW);
    for (int it = blockIdx.x * NTHR + tid_l; it < NGRP * 256 * 32; it += F.G * NTHR) {
        const int g = it >> 13, r = (it >> 5) & 255, jc = it & 31, i = r >> 4, h = r & 15, j = jc >> 1, hp0 = (jc & 1) * 8;
        v4u o = (v4u){0u, 0u, 0u, 0u};
        if (j <= i) { const float* k = Kt + ((g * 16 + (i - j)) * 16 + h) * 16 + hp0; const f32x4 k0 = *(const f32x4*)k, k1 = *(const f32x4*)(k + 4);
            o.x = pk2(k0[0], k0[1]); o.y = pk2(k0[2], k0[3]); o.z = pk2(k1[0], k1[1]); o.w = pk2(k1[2], k1[3]); }
        *(v4u*)(Tw + (size_t)(g * 256 + r) * KSS + j * 16 + hp0) = o;
    }
}
__device__ __forceinline__ void rows_norm_mod(Frame& F, const float* x, const float* g, const float* sh, const float* sc, bf16* H) {
    int tid_l = F.wave * 64 + (int)__builtin_amdgcn_mbcnt_hi(~0u, __builtin_amdgcn_mbcnt_lo(~0u, 0u)); asm volatile("" : "+v"(tid_l)); const int lane_l = tid_l & 63;
    const int gw = blockIdx.x * NWAVES + F.wave, NGW = F.G * NWAVES;
    for (int m = 2 * gw; m < M; m += 2 * NGW) {
        const int b = m >> 11; const f32x4* xr = (const f32x4*)(x + (size_t)m * DM) + lane_l;
        f32x4 v[2][4]; float s0 = 0.f, s1 = 0.f;
#pragma unroll
        for (int j = 0; j < 4; ++j) { v[0][j] = xr[64 * j]; v[1][j] = xr[256 + 64 * j]; }
#pragma unroll
        for (int j = 0; j < 4; ++j) { s0 += (v[0][j][0] * v[0][j][0] + v[0][j][1] * v[0][j][1]) + (v[0][j][2] * v[0][j][2] + v[0][j][3] * v[0][j][3]);
                                      s1 += (v[1][j][0] * v[1][j][0] + v[1][j][1] * v[1][j][1]) + (v[1][j][2] * v[1][j][2] + v[1][j][3] * v[1][j][3]); }
        const float r0 = 1.0f / sqrtf(wave_sum(s0) * (1.0f / DM) + EPS), r1 = 1.0f / sqrtf(wave_sum(s1) * (1.0f / DM) + EPS);
        v2u* o8 = (v2u*)(H + (size_t)m * DM) + lane_l;
#pragma unroll
        for (int j = 0; j < 4; ++j) { const int col = 4 * lane_l + 256 * j;
            const f32x4 g4 = *(const f32x4*)(g + col) * (1.0f + *(const f32x4*)(sc + (size_t)b * NMOD + col)), h4 = *(const f32x4*)(sh + (size_t)b * NMOD + col);
            const f32x4 o0 = v[0][j] * r0 * g4 + h4, o1 = v[1][j] * r1 * g4 + h4;
            o8[64 * j] = (v2u){pk2(o0[0], o0[1]), pk2(o0[2], o0[3])}; o8[256 + 64 * j] = (v2u){pk2(o1[0], o1[1]), pk2(o1[2], o1[3])}; }
    }
}
template <bool NORM> __device__ __forceinline__ void rows_residual(Frame& F, const float* xin, float* xout, const bf16* f, const float* fss, float coef, const float* ga, const float* gpost,
                                                                    const float* gpre, const float* sh, const float* sc, bf16* H) {
    int tid_l = F.wave * 64 + (int)__builtin_amdgcn_mbcnt_hi(~0u, __builtin_amdgcn_mbcnt_lo(~0u, 0u)); asm volatile("" : "+v"(tid_l)); const int lane_l = tid_l & 63;
    const int gw = blockIdx.x * NWAVES + F.wave, NGW = F.G * NWAVES;
    for (int m = gw; m < M; m += NGW) {
        const int b = m >> 11; const f32x4* xr = (const f32x4*)(xin + (size_t)m * DM) + lane_l; const v2u* fr = (const v2u*)(f + (size_t)m * DM) + lane_l;
        float q = (lane_l < 16) ? fss[(size_t)m * 16 + lane_l] : 0.f; q = wave_sum(q);
        const float rf = coef / sqrtf(q * (1.0f / DM) + EPS);
        f32x4 v[4]; float s = 0.f;
#pragma unroll
        for (int j = 0; j < 4; ++j) { const int col = 4 * lane_l + 256 * j; const f32x4 xv = xr[64 * j]; const v2u fw = fr[64 * j];
            const f32x4 ga4 = *(const f32x4*)(ga + (size_t)b * NMOD + col), gp4 = *(const f32x4*)(gpost + col);
            const f32x4 fv = (f32x4){bflo(fw.x), bfhi(fw.x), bflo(fw.y), bfhi(fw.y)};
            v[j] = xv + ga4 * gp4 * fv * rf;
            s += (v[j][0] * v[j][0] + v[j][1] * v[j][1]) + (v[j][2] * v[j][2] + v[j][3] * v[j][3]); }
        f32x4* xo = (f32x4*)(xout + (size_t)m * DM) + lane_l;
#pragma unroll
        for (int j = 0; j < 4; ++j) xo[64 * j] = v[j];
        if (NORM) {
            const float rstd = 1.0f / sqrtf(wave_sum(s) * (1.0f / DM) + EPS);
            v2u* o8 = (v2u*)(H + (size_t)m * DM) + lane_l;
#pragma unroll
            for (int j = 0; j < 4; ++j) { const int col = 4 * lane_l + 256 * j;
                const f32x4 g4 = *(const f32x4*)(gpre + col), s4 = *(const f32x4*)(sc + (size_t)b * NMOD + col), h4 = *(const f32x4*)(sh + (size_t)b * NMOD + col);
                const f32x4 o = v[j] * rstd * g4 * (1.0f + s4) + h4;
                o8[64 * j] = (v2u){pk2(o[0], o[1]), pk2(o[2], o[3])}; }
        }
    }
}
__device__ __forceinline__ void rows_ssm_norm(Frame& F, const bf16* sr, const float* sss, const float* g, bf16* MX) {
    int tid_l = F.wave * 64 + (int)__builtin_amdgcn_mbcnt_hi(~0u, __builtin_amdgcn_mbcnt_lo(~0u, 0u)); asm volatile("" : "+v"(tid_l)); const int lane_l = tid_l & 63;
    const int gw = blockIdx.x * NWAVES + F.wave, NGW = F.G * NWAVES;
    for (int m = gw; m < M; m += NGW) {
        float q = (lane_l < 8) ? sss[(size_t)m * 8 + lane_l] : 0.f; q = wave_sum(q);
        const float r = 1.0f / sqrtf(q * (1.0f / DSSM) + EPS);
        const v4u w = *((const v4u*)(sr + (size_t)m * DSSM) + lane_l);
        const f32x4 g0 = *(const f32x4*)(g + 8 * lane_l), g1 = *(const f32x4*)(g + 8 * lane_l + 4);
        v4u o; o.x = pk2(bflo(w.x) * r * g0[0], bfhi(w.x) * r * g0[1]); o.y = pk2(bflo(w.y) * r * g0[2], bfhi(w.y) * r * g0[3]);
        o.z = pk2(bflo(w.z) * r * g1[0], bfhi(w.z) * r * g1[1]); o.w = pk2(bflo(w.w) * r * g1[2], bfhi(w.w) * r * g1[3]);
        *((v4u*)(MX + (size_t)m * DM + DATT) + lane_l) = o;
    }
}
constexpr int SS_WS = 0, SS_WROW = 528, SS_S = 128 * SS_WROW;
__device__ __forceinline__ void ssm_state_scan(Frame& F, const Args& a) {
    int tid_l = F.wave * 64 + (int)__builtin_amdgcn_mbcnt_hi(~0u, __builtin_amdgcn_mbcnt_lo(~0u, 0u)); asm volatile("" : "+v"(tid_l)); const int lane_l = tid_l & 63;
    bf16* As = (bf16*)(a.ws + WS_AS); const bf16* WS = (const bf16*)(a.ws + WS_WS); const float* A16 = (const float*)(a.ws + WS_A16);
    const int r = lane_l & 31, h = lane_l >> 5, rt = F.wave >> 1, ct0 = 2 * (F.wave & 1);
    LAS float* SlA = (LAS float*)(F.lds + SS_S); LAS float* SlB = (LAS float*)(F.lds + SS_WS);
    for (int item = blockIdx.x; item < NGRP * (NB / 2); item += F.G) {
        const int g = item & 31, b0 = 2 * (item >> 5);
        __syncthreads();
        f32x16 accA[2], accB[2];
        {
            v4u wv[8];
#pragma unroll
            for (int it = 0; it < 8; ++it) { const int id = it * NTHR + tid_l; wv[it] = *(const v4u*)(WS + (size_t)(g * 128 + (id >> 5)) * 256 + (id & 31) * 8); }
            bf16x8 afA[16], afB[16];
            const bf16* ap = As + (size_t)(g * 2048 + b0 * 128 + rt * 32 + r) * KSS + 8 * h;
#pragma unroll
            for (int kk = 0; kk < 16; ++kk) afA[kk] = *(const bf16x8*)(ap + kk * 16);
#pragma unroll
            for (int kk = 0; kk < 16; ++kk) afB[kk] = *(const bf16x8*)(ap + (size_t)128 * KSS + kk * 16);
#pragma unroll
            for (int it = 0; it < 8; ++it) { const int id = it * NTHR + tid_l; *(LAS v4u*)(F.lds + SS_WS + (id >> 5) * SS_WROW + (id & 31) * 16) = wv[it]; }
            __syncthreads();
#pragma unroll
            for (int t = 0; t < 2; ++t)
#pragma unroll
                for (int e = 0; e < 16; ++e) { accA[t][e] = 0.f; accB[t][e] = 0.f; }
#pragma unroll
            for (int kk = 0; kk < 16; ++kk)
#pragma unroll
                for (int t = 0; t < 2; ++t) { const bf16x8 bfr = *(const LAS bf16x8*)(F.lds + SS_WS + ((ct0 + t) * 32 + r) * SS_WROW + (kk * 16 + 8 * h) * 2);
                    accA[t] = __builtin_amdgcn_mfma_f32_32x32x16_bf16(afA[kk], bfr, accA[t], 0, 0, 0);
                    accB[t] = __builtin_amdgcn_mfma_f32_32x32x16_bf16(afB[kk], bfr, accB[t], 0, 0, 0); }
        }
#pragma unroll
        for (int t = 0; t < 2; ++t)
#pragma unroll
            for (int e = 0; e < 16; ++e) { const int row = (e & 3) + 8 * (e >> 2) + 4 * h; SlA[(rt * 32 + row) * 128 + (ct0 + t) * 32 + r] = accA[t][e]; }
        __syncthreads();
#pragma unroll
        for (int t = 0; t < 2; ++t)
#pragma unroll
            for (int e = 0; e < 16; ++e) { const int row = (e & 3) + 8 * (e >> 2) + 4 * h; SlB[(rt * 32 + row) * 128 + (ct0 + t) * 32 + r] = accB[t][e]; }
        __syncthreads();
        if (F.wave < 2) {
            const int p = lane_l, b = b0 + F.wave; const LAS float* Sl = F.wave ? SlB : SlA;
            const float ar = A16[g * 64 + p], ai = A16[NGRP * 64 + g * 64 + p];
            float xr = 0.f, xi = 0.f; bf16* xp = As + (size_t)(g * 2048 + b * 128) * KSS + 256 + p;
#pragma unroll 8
            for (int c = 0; c < 128; ++c) {
                xp[(size_t)c * KSS] = (bf16)f2bf(xr); xp[(size_t)c * KSS + 64] = (bf16)f2bf(xi);
                const float sr = Sl[c * 128 + p], si = Sl[c * 128 + 64 + p];
                const float nr = ar * xr - ai * xi + sr, ni = ar * xi + ai * xr + si; xr = nr; xi = ni; }
        }
    }
    __syncthreads();
}
#ifdef ATT_STAMPS
#define ATT_STAMP(k) do { if (blockIdx.x == 0 && tid_l == 0) ((volatile LAS unsigned*)(F.lds + LDS_MISC_OFF + 64))[48 + (k)] = (unsigned)__builtin_amdgcn_s_memrealtime(); } while (0)
#else
#define ATT_STAMP(k) do {} while (0)
#endif
constexpr int AT_K = 0, AT_VT = 65536, AT_VTH = 33280  , AT_X = AT_VT + 2 * AT_VTH  ;
__device__ __forceinline__ void attn_phase(Frame& F, const Args& a) {
    int tid_l = F.wave * 64 + (int)__builtin_amdgcn_mbcnt_hi(~0u, __builtin_amdgcn_mbcnt_lo(~0u, 0u)); asm volatile("" : "+v"(tid_l)); const int lane_l = tid_l & 63;
    const bf16* Qg = (const bf16*)(a.ws + WS_Q); const bf16* Kg = (const bf16*)(a.ws + WS_K); const bf16* Vg = (const bf16*)(a.ws + WS_V); bf16* MX = (bf16*)(a.ws + WS_H);
    const float* sinks = a.in[I_SINKS]; const float* gat = a.in[I_GATT];
    const int hq = F.wave, kvh = hq >> 2;
    const float slope2 = exp2f(-(float)(hq + 1)) * pg8::LOG2E, sink2 = sinks[hq] * pg8::LOG2E, qscale = 0.125f * pg8::LOG2E;
    LAS float* xch = (LAS float*)(F.lds + AT_X);
    for (int unit = blockIdx.x; unit < NB * (SEQ / 128); unit += F.G) {
        const int b = unit >> 4, nb = unit & 15; const size_t tok0 = (size_t)b * SEQ + (size_t)nb * 128;
        ATT_STAMP(0);
        int tl = tid_l; asm volatile("" : "+v"(tl)); const int r = tl & 31, h = (tl >> 5) & 1;
        __syncthreads();
        {
            v4u kv[8], vv[8];
            const int cc0 = tl & 15, kj0 = tl >> 4;
            const bf16* kp = Kg + (tok0 - 128 + kj0) * 128 + cc0 * 8; const bf16* vp = Vg + (tok0 - 128 + kj0) * 128 + cc0 * 8;
#pragma unroll
            for (int it = 0; it < 8; ++it) {
                kv[it] = (v4u){0u, 0u, 0u, 0u}; vv[it] = (v4u){0u, 0u, 0u, 0u};
                if (nb > 0 || it >= 4) { kv[it] = *(const v4u*)kp; vv[it] = *(const v4u*)vp; }
                kp += 32 * 128; vp += 32 * 128; asm volatile("" : "+v"(kp), "+v"(vp)); }
#pragma unroll
            for (int it = 0; it < 8; ++it) { const int id = it * NTHR + tl, kj = id >> 4, cc = id & 15, kh = cc >> 3, c = cc & 7;
                *(LAS v4u*)(F.lds + AT_K + kh * 32768 + kj * 128 + ((c ^ (kj & 7)) << 4)) = kv[it];
                LAS unsigned short* vt = (LAS unsigned short*)(F.lds + AT_VT + kh * AT_VTH + (c * 8) * 520) + kj; const v4u v = vv[it];
                vt[0 * 260] = (unsigned short)(v.x & 0xffffu); vt[1 * 260] = (unsigned short)(v.x >> 16); vt[2 * 260] = (unsigned short)(v.y & 0xffffu); vt[3 * 260] = (unsigned short)(v.y >> 16);
                vt[4 * 260] = (unsigned short)(v.z & 0xffffu); vt[5 * 260] = (unsigned short)(v.z >> 16); vt[6 * 260] = (unsigned short)(v.w & 0xffffu); vt[7 * 260] = (unsigned short)(v.w >> 16); }
        }
        bf16x8 qf[4];
        { const bf16* qp = Qg + (tok0 + r) * DATT + hq * 64 + 8 * h;
#pragma unroll
          for (int s4 = 0; s4 < 4; ++s4) qf[s4] = *(const bf16x8*)(qp + 16 * s4); }
        __syncthreads();
        ATT_STAMP(1);
        const LAS unsigned char* Kl = F.lds + AT_K + kvh * 32768; const LAS unsigned char* Vl = F.lds + AT_VT + kvh * AT_VTH;
#pragma unroll 1
        for (int qt = 0; qt < 4; ++qt) {
            f32x16 sc[5];
            float rb = -slope2 * (float)(r - 4 * h); asm volatile("" : "+v"(rb));
#pragma unroll
            for (int t5 = 0; t5 < 5; ++t5) {
#pragma unroll
                for (int e = 0; e < 16; ++e) sc[t5][e] = rb - slope2 * (float)(128 - 32 * t5 - ((e & 3) + 8 * (e >> 2)));
                const int key = 32 * (qt + t5) + r;
#pragma unroll
                for (int s4 = 0; s4 < 4; ++s4) { const bf16x8 kf = *(const LAS bf16x8*)(Kl + key * 128 + (((2 * s4 + h) ^ (key & 7)) << 4));
                    sc[t5] = __builtin_amdgcn_mfma_f32_32x32x16_bf16(kf, qf[s4], sc[t5], 0, 0, 0); }
            }
            if (qt < 3) { const bf16* qp = Qg + (tok0 + 32 * (qt + 1) + r) * DATT + hq * 64 + 8 * h;
#pragma unroll
                for (int s4 = 0; s4 < 4; ++s4) qf[s4] = *(const bf16x8*)(qp + 16 * s4); }
            float mx = sink2;
#pragma unroll
            for (int e = 0; e < 16; ++e) { const int koff = (e & 3) + 8 * (e >> 2) + 4 * h;
                sc[0][e] = (koff > r) ? sc[0][e] : -1e30f; sc[4][e] = (koff <= r) ? sc[4][e] : -1e30f; }
            if (nb == 0) {
#pragma unroll
                for (int t5 = 0; t5 < 4; ++t5) if (qt + t5 < 4) {
#pragma unroll
                    for (int e = 0; e < 16; ++e) sc[t5][e] = -1e30f; }
            }
#pragma unroll
            for (int t5 = 0; t5 < 5; ++t5)
#pragma unroll
                for (int e = 0; e < 16; e += 2) mx = fmaxf(fmaxf(mx, sc[t5][e]), sc[t5][e + 1]);
            mx = fmaxf(mx, __shfl_xor(mx, 32));
            float sum = 0.f;
#pragma unroll
            for (int t5 = 0; t5 < 5; ++t5)
#pragma unroll
                for (int e = 0; e < 16; ++e) { const float pv = __builtin_amdgcn_exp2f(sc[t5][e] - mx); sc[t5][e] = pv; sum += pv; }
            sum += __shfl_xor(sum, 32);
            const float inv = 1.0f / (sum + __builtin_amdgcn_exp2f(sink2 - mx));
            f32x16 o[2];
#pragma unroll
            for (int dt = 0; dt < 2; ++dt)
#pragma unroll
                for (int e = 0; e < 16; ++e) o[dt][e] = 0.f;
#pragma unroll
            for (int t5 = 0; t5 < 5; ++t5)
#pragma unroll
                for (int s2 = 0; s2 < 2; ++s2) {
                    v4u pw; pw.x = pk2(sc[t5][8 * s2 + 0], sc[t5][8 * s2 + 1]); pw.y = pk2(sc[t5][8 * s2 + 2], sc[t5][8 * s2 + 3]);
                    pw.z = pk2(sc[t5][8 * s2 + 4], sc[t5][8 * s2 + 5]); pw.w = pk2(sc[t5][8 * s2 + 6], sc[t5][8 * s2 + 7]);
                    const bf16x8 pf = __builtin_bit_cast(bf16x8, pw);
                    const int key0 = 32 * (qt + t5) + 16 * s2 + 4 * h;
#pragma unroll
                    for (int dt = 0; dt < 2; ++dt) { const LAS unsigned char* vp = Vl + (dt * 32 + r) * 520 + key0 * 2;
                        const v2u lo = *(const LAS v2u*)vp, hi = *(const LAS v2u*)(vp + 16);
                        const v4u vw = (v4u){lo.x, lo.y, hi.x, hi.y};
                        o[dt] = __builtin_amdgcn_mfma_f32_32x32x16_bf16(__builtin_bit_cast(bf16x8, vw), pf, o[dt], 0, 0, 0); }
                }
            float ssq = 0.f;
#pragma unroll
            for (int dt = 0; dt < 2; ++dt)
#pragma unroll
                for (int e = 0; e < 16; ++e) { o[dt][e] *= inv; ssq += o[dt][e] * o[dt][e]; }
            ssq += __shfl_xor(ssq, 32);
            LAS float* xb = xch + (qt & 1) * 256;
            if (h == 0) xb[r * 8 + hq] = ssq;
            __syncthreads();
            const f32x4 t0 = *(const LAS f32x4*)(xb + r * 8), t1 = *(const LAS f32x4*)(xb + r * 8 + 4);
            const float tot = ((t0[0] + t0[1]) + (t0[2] + t0[3])) + ((t1[0] + t1[1]) + (t1[2] + t1[3]));
            const float rn = 1.0f / sqrtf(tot * (1.0f / DATT) + EPS);
            bf16* op = MX + (tok0 + 32 * qt + r) * DM + hq * 64 + 4 * h;
            const float* gp = gat + hq * 64; asm volatile("" : "+s"(gp));
#pragma unroll
            for (int dt = 0; dt < 2; ++dt)
#pragma unroll
                for (int k4 = 0; k4 < 4; ++k4) { const f32x4 g4 = *(const f32x4*)(gp + dt * 32 + 8 * k4 + 4 * h);
                    const v2u w = (v2u){pk2(o[dt][4 * k4 + 0] * rn * g4[0], o[dt][4 * k4 + 1] * rn * g4[1]), pk2(o[dt][4 * k4 + 2] * rn * g4[2], o[dt][4 * k4 + 3] * rn * g4[3])};
                    *(v2u*)(op + dt * 32 + 8 * k4) = w; }
            if (qt == 0) ATT_STAMP(2); if (qt == 3) ATT_STAMP(3);
        }
    }
    __syncthreads();
}
#ifndef REP0
#define REP0 1
#endif
#ifndef REP1
#define REP1 1
#endif
#ifndef REP2
#define REP2 1
#endif
#ifndef REP3
#define REP3 1
#endif
#ifndef REP4
#define REP4 1
#endif
#ifndef REP5
#define REP5 1
#endif
#ifndef REP6
#define REP6 1
#endif
#ifndef REP7
#define REP7 1
#endif
#ifndef REP8
#define REP8 1
#endif
#ifndef REP9
#define REP9 1
#endif
#ifndef REP10
#define REP10 1
#endif
#ifndef REP11
#define REP11 1
#endif
#ifndef REP12
#define REP12 1
#endif
#ifndef REP13
#define REP13 1
#endif
#ifndef REP14
#define REP14 1
#endif
#ifndef REP15
#define REP15 1
#endif
#ifndef GU_ALIGN
#define GU_ALIGN true
#endif
#ifndef GU_SP2
#define GU_SP2 true
#endif
#ifndef EPI_DBG1
#define EPI_DBG1 0
#endif
#ifndef EPI_DBG2
#define EPI_DBG2 0
#endif
#ifndef EPI_DBG3
#define EPI_DBG3 0
#endif
#ifndef GU_WGM
#define GU_WGM 8
#endif
#ifndef DOWN_REV
#define DOWN_REV 0
#endif
#ifndef XSYNC
#define XSYNC 0
#endif
#ifndef STAG13
#define STAG13 0
#endif
#ifndef STAG3
#define STAG3 0
#endif
#ifndef STAG10
#define STAG10 0
#endif
__device__ __forceinline__ void stagger_us(int us) {
    if (us > 0 && (blockIdx.x & 1)) { const unsigned long long t0 = __builtin_amdgcn_s_memrealtime(); while (__builtin_amdgcn_s_memrealtime() - t0 < (unsigned long long)us * 100ull) __builtin_amdgcn_s_sleep(8); }
}
__global__ void __launch_bounds__(NTHR, 2) fwd_megakernel(Args args) {
    extern __shared__ __attribute__((aligned(16))) unsigned char lds_raw[];
    Frame F; F.lds = (LAS unsigned char*)lds_raw; F.tid = threadIdx.x; F.lane = F.tid & 63; F.wave = __builtin_amdgcn_readfirstlane(F.tid >> 6); F.G = gridDim.x;
    unsigned char* ws = args.ws; unsigned* ctl = (unsigned*)(ws + WS_CTL);
    { volatile LAS unsigned* misc = (volatile LAS unsigned*)(F.lds + LDS_MISC_OFF); if (F.tid < 128) misc[F.tid] = 0u; }
    __syncthreads();
    const XcdBarrier bar = xcd_barrier_post((unsigned*)(ws + WS_CTL) + CW_BAR, (volatile LAS unsigned*)(F.lds + LDS_MISC_OFF) + 8);
#ifndef STAMP_BLK
#define STAMP_BLK 0
#endif
#ifdef STAMP_A
    volatile LAS unsigned* tsl = (volatile LAS unsigned*)(F.lds + LDS_MISC_OFF + 64); int n_stamp = 0;
#define STAMP() do { if (blockIdx.x == STAMP_BLK && F.tid == 0) { tsl[n_stamp] = (unsigned)__builtin_amdgcn_s_memrealtime(); } ++n_stamp; } while (0)
#define PRESTAMP() do { if (blockIdx.x == STAMP_BLK && F.tid == 0) tsl[16 + n_stamp] = (unsigned)__builtin_amdgcn_s_memrealtime(); } while (0)
#else
#define STAMP() do {} while (0)
#define PRESTAMP() do {} while (0)
#endif
#ifdef SUBSTAMPS
#define SUBSTAMP() STAMP()
#else
#define SUBSTAMP() do {} while (0)
#endif
    STAMP();
    const float* mod = (const float*)(ws + WS_MOD);
    bf16* H = (bf16*)(ws + WS_H); bf16* ACT = (bf16*)(ws + WS_ACT); bf16* Fb = (bf16*)(ws + WS_F); float* FSS = (float*)(ws + WS_FSS); float* SSS = (float*)(ws + WS_SSS);
    const float* x = args.in[I_X]; float* out = args.out;

    for (int rep_ = 0; rep_ < REP0; ++rep_) { if (rep_) xcd_barrier(bar);
    p0_zero_slots(F, args);
    p0_mod(F, args); __syncthreads();
    p0_ssm(F, args); __syncthreads();
    p0_weights<0>(F, args);
    }
    PRESTAMP(); xcd_barrier(bar); STAMP();
    for (int rep_ = 0; rep_ < REP1; ++rep_) { if (rep_) xcd_barrier(bar);
    rows_norm_mod(F, x, args.in[I_GPRE1], mod + 0 * DM, mod + 1 * DM, H);
    p1_toeplitz(F, args);
    }
    PRESTAMP(); xcd_barrier(bar); STAMP();
    for (int rep_ = 0; rep_ < REP2; ++rep_) { if (rep_) xcd_barrier(bar);
    { pg8::Gemm g{H, (const bf16*)(ws + WS_W1GU), M, 2 * DFF, DM}; pg8::StaticOrder S; S.init(M, 2 * DFF, F.G, (int)blockIdx.x, GU_WGM);
      pg8::EpiSwiGLU E{ACT, DFF, DOWN_BLK}; pg8::gemm_phase<pg8::EpiSwiGLU, pg8::StaticOrder, GU_ALIGN, GU_SP2>(F.lds, g, S, E, F.wave); }
    }
    PRESTAMP(); xcd_barrier(bar); STAMP();
    for (int rep_ = 0; rep_ < REP3; ++rep_) { if (rep_) xcd_barrier(bar);
    stagger_us(STAG3);
    { pg8::Gemm g{ACT, (const bf16*)(ws + WS_W1D), M, DM, DFF, DOWN_BLK, DOWN_BLK}; pg8::StaticOrder S; S.init(M, DM, F.G, (int)blockIdx.x, 8, DOWN_REV);
      pg8::EpiResNorm<true> E{x, out, H, mod + 2 * DM, args.in[I_GPOST1], args.in[I_GPREM], mod + 3 * DM, mod + 4 * DM, NMOD, pg8::RowStats{(unsigned long long*)(ws + WS_XB) + 0 * (size_t)M, ctl + CW_TMO, 4, 1.0f / DM, EPS, 0.5f}, pg8::RowStats{(unsigned long long*)(ws + WS_XB) + 1 * (size_t)M, ctl + CW_TMO, 4, 1.0f / DM, EPS, 1.0f}, F.lds + LDS_X_OFF, EPI_DBG1, x, (float*)(ws + WS_ACT)};
      pg8::gemm_phase<pg8::EpiResNorm<true>, pg8::StaticOrder, true, true>(F.lds, g, S, E, F.wave); }
    }
    PRESTAMP(); xcd_barrier(bar); STAMP();
    for (int rep_ = 0; rep_ < REP5; ++rep_) { if (rep_) xcd_barrier(bar);
    { pg8::Gemm g{H, (const bf16*)(ws + WS_WIN), M, DIN, DM}; pg8::StaticOrder S; S.init(M, DIN, F.G, (int)blockIdx.x);
      pg8::EpiWin E{(bf16*)(ws + WS_Q), (bf16*)(ws + WS_K), (bf16*)(ws + WS_V), (bf16*)(ws + WS_AS)}; pg8::gemm_phase<pg8::EpiWin, pg8::StaticOrder, true, true>(F.lds, g, S, E, F.wave); }
    p0_weights<1>(F, args);
    }
    PRESTAMP(); xcd_barrier(bar); STAMP();
    for (int rep_ = 0; rep_ < REP6; ++rep_) { if (rep_) xcd_barrier(bar);
    ssm_state_scan(F, args);
    attn_phase(F, args);
#ifdef FUSE_Y
    if ((int)blockIdx.x < 256) { asm volatile("s_waitcnt vmcnt(0)" ::: "memory"); __syncthreads();
      pg8::Gemm g{(const bf16*)(ws + WS_AS), (const bf16*)(ws + WS_TW), NGRP * 2048, NGRP * 256, KSS}; pg8::OneUnit S{(int)blockIdx.x, (int)blockIdx.x >> 3};
      pg8::EpiSsmY E{(bf16*)(ws + WS_YG)}; pg8::gemm_phase<pg8::EpiSsmY, pg8::OneUnit, true, true>(F.lds, g, S, E, F.wave); }
#endif
    }
    PRESTAMP(); xcd_barrier(bar); STAMP();
#ifndef FUSE_Y
    for (int rep_ = 0; rep_ < REP8; ++rep_) { if (rep_) xcd_barrier(bar);
    { pg8::Gemm g{(const bf16*)(ws + WS_AS), (const bf16*)(ws + WS_TW), NGRP * 2048, NGRP * 256, KSS}; pg8::SsmOrder S{F.G, (int)blockIdx.x};
      pg8::EpiSsmY E{(bf16*)(ws + WS_YG)}; pg8::gemm_phase<pg8::EpiSsmY, pg8::SsmOrder, true, true>(F.lds, g, S, E, F.wave); }
    }
    PRESTAMP(); xcd_barrier(bar); STAMP();
#endif
    for (int rep_ = 0; rep_ < REP9; ++rep_) { if (rep_) xcd_barrier(bar);
    { pg8::Gemm g{(const bf16*)(ws + WS_YG), (const bf16*)(ws + WS_WGLU), M, DSSM, DSSM}; pg8::StaticOrder S; S.init(M, DSSM, F.G, (int)blockIdx.x);
      pg8::EpiGluNorm E{(const bf16*)(ws + WS_YG), H, args.in[I_BGLU], args.in[I_GSSM], pg8::RowStats{(unsigned long long*)(ws + WS_XB) + 5 * (size_t)M, ctl + CW_TMO, 2, 1.0f / DSSM, EPS, 1.0f}, F.lds + LDS_X_OFF};
      pg8::gemm_phase<pg8::EpiGluNorm, pg8::StaticOrder, true, true>(F.lds, g, S, E, F.wave); }
    }
    PRESTAMP(); xcd_barrier(bar); STAMP();
    for (int rep_ = 0; rep_ < REP11; ++rep_) { if (rep_) xcd_barrier(bar);
    stagger_us(STAG10);
    { pg8::Gemm g{H, (const bf16*)(ws + WS_WOUT), M, DM, DM}; pg8::StaticOrder S; S.init(M, DM, F.G, (int)blockIdx.x);
      pg8::EpiResNorm<true> E{out, out, H, mod + 5 * DM, args.in[I_GPOSTM], args.in[I_GPRE2], mod + 6 * DM, mod + 7 * DM, NMOD, pg8::RowStats{(unsigned long long*)(ws + WS_XB) + 2 * (size_t)M, ctl + CW_TMO, 4, 1.0f / DM, EPS, 1.0f}, pg8::RowStats{(unsigned long long*)(ws + WS_XB) + 3 * (size_t)M, ctl + CW_TMO, 4, 1.0f / DM, EPS, 1.0f}, F.lds + LDS_X_OFF, EPI_DBG2, x, (float*)(ws + WS_ACT)};
      pg8::gemm_phase<pg8::EpiResNorm<true>, pg8::StaticOrder, true, true>(F.lds, g, S, E, F.wave); }
    }
    PRESTAMP(); xcd_barrier(bar); STAMP();
    for (int rep_ = 0; rep_ < REP14; ++rep_) { if (rep_) xcd_barrier(bar);
    { pg8::Gemm g{H, (const bf16*)(ws + WS_W2GU), M, 2 * DFF, DM}; pg8::StaticOrder S; S.init(M, 2 * DFF, F.G, (int)blockIdx.x, GU_WGM);
      pg8::EpiSwiGLU E{ACT, DFF, DOWN_BLK}; pg8::gemm_phase<pg8::EpiSwiGLU, pg8::StaticOrder, GU_ALIGN, GU_SP2>(F.lds, g, S, E, F.wave); }
    }
    PRESTAMP(); xcd_barrier(bar); STAMP();
    for (int rep_ = 0; rep_ < REP15; ++rep_) { if (rep_) xcd_barrier(bar);
    stagger_us(STAG13);
    { pg8::Gemm g{ACT, (const bf16*)(ws + WS_W2D), M, DM, DFF, DOWN_BLK, DOWN_BLK}; pg8::StaticOrder S; S.init(M, DM, F.G, (int)blockIdx.x, 8, DOWN_REV);
      pg8::EpiResNorm<false> E{out, out, H, mod + 8 * DM, args.in[I_GPOST2], args.in[I_GPOST2], mod + 8 * DM, mod + 8 * DM, NMOD, pg8::RowStats{(unsigned long long*)(ws + WS_XB) + 4 * (size_t)M, ctl + CW_TMO, 4, 1.0f / DM, EPS, 0.5f}, pg8::RowStats{(unsigned long long*)(ws + WS_XB) + 4 * (size_t)M, ctl + CW_TMO, 4, 1.0f / DM, EPS, 1.0f}, F.lds + LDS_X_OFF, EPI_DBG3, x, (float*)(ws + WS_ACT)};
      pg8::gemm_phase<pg8::EpiResNorm<false>, pg8::StaticOrder, true, true>(F.lds, g, S, E, F.wave); }
    }
    for (int xs_ = 0; xs_ < XSYNC; ++xs_) xcd_barrier(bar);
#ifdef STAMP_A
    PRESTAMP(); xcd_barrier(bar); STAMP();
#ifdef STAMP_CLK
    if (blockIdx.x == 0 && F.tid == 0) out[0] += (float)(tsl[16 + STAMP_B] - tsl[16 + STAMP_A]) / (float)(tsl[STAMP_B] - tsl[STAMP_A]) * STAMP_SCALE;
#else
    if (blockIdx.x == STAMP_BLK && F.tid == 0) out[0] += (float)(tsl[STAMP_B] - tsl[STAMP_A]) * STAMP_SCALE;
#endif
#endif
}

extern "C" void kernel_launch(void* const* d_in, const int* in_sizes, int n_in, void* d_out, int out_size, void* d_ws, size_t ws_size, hipStream_t stream) {
    static int grid = 0;
    if (grid == 0) {
        if (n_in != 31 || in_sizes[0] != M * DM || out_size != M * DM || ws_size < WS_END) {
            fprintf(stderr, "kernel_launch: unexpected shapes (n_in %d, in0 %d, out %d, ws %zu, need %zu); nothing launched\n", n_in, n_in > 0 ? in_sizes[0] : -1, out_size, ws_size, (size_t)WS_END); grid = -1; return; }
        int dev = 0, cus = 0, per_cu = 0;
        if (hipGetDevice(&dev) != hipSuccess || hipDeviceGetAttribute(&cus, hipDeviceAttributeMultiprocessorCount, dev) != hipSuccess) { fprintf(stderr, "kernel_launch: device query failed\n"); grid = -1; return; }
        if (hipFuncSetAttribute((const void*)fwd_megakernel, hipFuncAttributeMaxDynamicSharedMemorySize, LDS_BYTES) != hipSuccess) { fprintf(stderr, "kernel_launch: hipFuncSetAttribute failed\n"); grid = -1; return; }
        if (hipOccupancyMaxActiveBlocksPerMultiprocessor(&per_cu, (const void*)fwd_megakernel, NTHR, LDS_BYTES) != hipSuccess || per_cu < 1) { fprintf(stderr, "kernel_launch: occupancy query says %d blocks per CU\n", per_cu); per_cu = 1; }
        (void)hipGetLastError();
        grid = cus < 256 ? cus : 256;
        fprintf(stderr, "kernel_launch: %d CUs, occupancy %d/CU, grid %d\n", cus, per_cu, grid);
    }
    if (grid < 0) return;
    if (hipMemsetAsync((char*)d_ws + WS_CTL, 0, CTL_ZERO_BYTES, stream) != hipSuccess) { fprintf(stderr, "kernel_launch: hipMemsetAsync failed\n"); return; }
    Args a{};
    for (int i = 0; i < 31; ++i) a.in[i] = (const float*)d_in[i];
    a.out = (float*)d_out; a.ws = (unsigned char*)d_ws;
    hipLaunchKernelGGL(fwd_megakernel, dim3(grid), dim3(NTHR), LDS_BYTES, stream, a);
    const hipError_t le = hipPeekAtLastError();
    if (le != hipSuccess) fprintf(stderr, "kernel_launch: launch failed: %s (grid %d)\n", hipGetErrorName(le), grid);
}
```
